# Optimizing an MI355X kernel written in HIP

```python
import math
import jax, jax.numpy as jnp
from jax import lax
import numpy as np

D_MODEL = 4096
BATCH = 4
SEQ = 2048
DEPTH = 1

MIX_WIDTH = D_MODEL
GDN_HEADS = 16
GDN_HEAD_DIM = 128
GDN_WIDTH = GDN_HEADS * GDN_HEAD_DIM
GDN_CONV = 4
GDN_CHUNK = 64
CONV_GROUPS = 16
CONV_GROUP_DIM = (MIX_WIDTH - GDN_WIDTH) // CONV_GROUPS
CONV_WIDTH = CONV_GROUPS * CONV_GROUP_DIM
SHORT_CONV = 3
IN_SIZES = [GDN_WIDTH, GDN_WIDTH, GDN_WIDTH,
            GDN_WIDTH,
            GDN_HEADS, GDN_HEADS,
            CONV_WIDTH, CONV_WIDTH, CONV_WIDTH]
IN_COLS = sum(IN_SIZES)
IN_SPLITS = np.cumsum(IN_SIZES)[:-1].tolist()

PEER_HEADS = 8
PEER_TOPK = 16
PEER_NKEYS = 128
PEER_EXPERTS = PEER_NKEYS * PEER_NKEYS
PEER_QDIM = 256
PEER_HALF = PEER_QDIM // 2
PEER_BLOCK = 128

DN_ALPHA = (2.0 * DEPTH) ** 0.25
DN_BETA = (8.0 * DEPTH) ** -0.25
LN_EPS = 1e-5
RMS_EPS = 1e-6

kernel_name = "hybrid_gdn_shortconv_peer_deepnorm"


def layer_norm(x, g, b):
    xf = x.astype(jnp.float32)
    mu = jnp.mean(xf, axis=-1, keepdims=True)
    var = jnp.mean(jnp.square(xf - mu), axis=-1, keepdims=True)
    y = (xf - mu) * lax.rsqrt(var + LN_EPS) * g.astype(jnp.float32) + b.astype(jnp.float32)
    return y.astype(x.dtype)


def l2_normalize(x):
    return x * lax.rsqrt(jnp.sum(jnp.square(x), axis=-1, keepdims=True) + RMS_EPS)


def causal_depthwise_conv(x, w):
    width = w.shape[0]
    seq = x.shape[1]
    xp = jnp.pad(x, ((0, 0), (width - 1, 0), (0, 0)))
    y = w[0] * xp[:, 0:seq]
    for j in range(1, width):
        y = y + w[j] * xp[:, j:j + seq]
    return y


def gated_delta_rule_chunked(q, k, v, g, beta):
    bsz, seq, heads, dk = q.shape
    dv = v.shape[-1]
    c = GDN_CHUNK
    n = seq // c
    q = l2_normalize(q) * (dk ** -0.5)
    k = l2_normalize(k)

    def to_chunks(t):
        return t.reshape(bsz, n, c, heads, -1).transpose(0, 3, 1, 2, 4)

    q, k, v = to_chunks(q), to_chunks(k), to_chunks(v)
    g = g.reshape(bsz, n, c, heads).transpose(0, 3, 1, 2)
    beta = beta.reshape(bsz, n, c, heads).transpose(0, 3, 1, 2)
    g = jnp.cumsum(g, axis=-1)

    causal = jnp.tril(jnp.ones((c, c), dtype=bool))
    strict = jnp.tril(jnp.ones((c, c), dtype=bool), -1)
    diff = g[..., :, None] - g[..., None, :]
    decay = jnp.where(causal, jnp.exp(jnp.where(causal, diff, 0.0)), 0.0)

    k_beta = k * beta[..., None]
    v_beta = v * beta[..., None]
    m = jnp.where(strict, jnp.einsum('bhnik,bhnjk->bhnij', k_beta, k) * decay, 0.0)
    rhs = jnp.concatenate([v_beta, k_beta * jnp.exp(g)[..., None]], axis=-1)
    sol = lax.linalg.triangular_solve(m, rhs, left_side=True, lower=True, unit_diagonal=True)
    u = sol[..., :dv]
    w = sol[..., dv:]
    qk = jnp.where(causal, jnp.einsum('bhnik,bhnjk->bhnij', q, k) * decay, 0.0)

    def step(state, inp):
        q_c, k_c, u_c, w_c, qk_c, g_c = inp
        v_new = u_c - jnp.einsum('bhck,bhkv->bhcv', w_c, state)
        o = (jnp.einsum('bhck,bhkv->bhcv', q_c * jnp.exp(g_c)[..., None], state)
             + jnp.einsum('bhij,bhjv->bhiv', qk_c, v_new))
        g_last = g_c[..., -1]
        k_dec = k_c * jnp.exp(g_last[..., None] - g_c)[..., None]
        state = state * jnp.exp(g_last)[..., None, None] + jnp.einsum('bhck,bhcv->bhkv', k_dec, v_new)
        return state, o

    xs = tuple(jnp.moveaxis(t, 2, 0) for t in (q, k, u, w, qk, g))
    state0 = jnp.zeros((bsz, heads, dk, dv), jnp.float32)
    _, o = lax.scan(step, state0, xs)
    return o.transpose(1, 0, 3, 2, 4).reshape(bsz, seq, heads, dv)


def hybrid_mixer(x, w_in, conv_qkv, a_log, dt_bias, gdn_norm_w, conv_short, w_out):
    bsz, seq, _ = x.shape
    proj = x @ w_in
    q, k, v, z, beta_raw, a_raw, gate_b, gate_c, h = jnp.split(proj, IN_SPLITS, axis=-1)

    qkv = jax.nn.silu(causal_depthwise_conv(jnp.concatenate([q, k, v], axis=-1), conv_qkv))
    q, k, v = jnp.split(qkv.astype(jnp.float32), 3, axis=-1)
    hd = (bsz, seq, GDN_HEADS, GDN_HEAD_DIM)
    beta = jax.nn.sigmoid(beta_raw.astype(jnp.float32))
    g = -jnp.exp(a_log.astype(jnp.float32)) * jax.nn.softplus(
        a_raw.astype(jnp.float32) + dt_bias.astype(jnp.float32))
    o = gated_delta_rule_chunked(q.reshape(hd), k.reshape(hd), v.reshape(hd), g, beta)
    o = o * lax.rsqrt(jnp.mean(jnp.square(o), axis=-1, keepdims=True) + RMS_EPS)
    o = o * gdn_norm_w.astype(jnp.float32) * jax.nn.silu(z.reshape(hd).astype(jnp.float32))
    o = o.reshape(bsz, seq, GDN_WIDTH).astype(x.dtype)

    sc = gate_b * causal_depthwise_conv(gate_c * h, conv_short)

    return jnp.concatenate([o, sc], axis=-1) @ w_out


def peer_ffn(x, w_q, sub_keys, w_down, w_up):
    bsz, seq, d = x.shape
    t = bsz * seq
    xt = x.reshape(t, d)
    q = (xt @ w_q).reshape(t, PEER_HEADS, 2, PEER_HALF)
    s = jnp.einsum('thpd,hpnd->thpn', q, sub_keys).astype(jnp.float32)
    s_top, i_top = lax.top_k(s, PEER_TOPK)
    cand = s_top[:, :, 0, :, None] + s_top[:, :, 1, None, :]
    cand_s, cand_pos = lax.top_k(cand.reshape(t, PEER_HEADS, PEER_TOPK * PEER_TOPK), PEER_TOPK)
    i1 = jnp.take_along_axis(i_top[:, :, 0], cand_pos // PEER_TOPK, axis=-1)
    i2 = jnp.take_along_axis(i_top[:, :, 1], cand_pos % PEER_TOPK, axis=-1)
    expert = i1 * PEER_NKEYS + i2
    gate = jax.nn.softmax(cand_s, axis=-1).astype(x.dtype)

    nb = t // PEER_BLOCK

    def block(args):
        xb, eb, gb = args
        u = jnp.take(w_down, eb, axis=0)
        a = jax.nn.gelu(jnp.einsum('bhkd,bd->bhk', u, xb), approximate=False) * gb
        v = jnp.take(w_up, eb, axis=0)
        return jnp.einsum('bhk,bhkd->bd', a, v)

    y = lax.map(block, (xt.reshape(nb, PEER_BLOCK, d),
                        expert.reshape(nb, PEER_BLOCK, PEER_HEADS, PEER_TOPK),
                        gate.reshape(nb, PEER_BLOCK, PEER_HEADS, PEER_TOPK)))
    return y.reshape(bsz, seq, d)


def setup_inputs(seed: int = 0) -> dict:
    key = jax.random.key(seed)
    ks = jax.random.split(key, 18)
    f32 = jnp.float32
    L, D = DEPTH, D_MODEL
    nrm = lambda k, shape, scale: jax.random.normal(k, shape, f32) * scale
    dt = jnp.exp(jax.random.uniform(ks[4], (L, GDN_HEADS), f32, math.log(1e-3), math.log(1e-1)))
    return {
        "x": jax.random.normal(ks[0], (BATCH, SEQ, D), f32),
        "w_in": nrm(ks[1], (L, D, IN_COLS), D ** -0.5),
        "conv_qkv": nrm(ks[2], (L, GDN_CONV, 3 * GDN_WIDTH), GDN_CONV ** -0.5),
        "a_log": jnp.log(jax.random.uniform(ks[3], (L, GDN_HEADS), f32, 1.0, 16.0)),
        "dt_bias": dt + jnp.log(-jnp.expm1(-dt)),
        "gdn_norm_w": 1.0 + nrm(ks[5], (L, GDN_HEAD_DIM), 0.01),
        "conv_short": nrm(ks[6], (L, SHORT_CONV, CONV_WIDTH), SHORT_CONV ** -0.5),
        "w_out": nrm(ks[7], (L, MIX_WIDTH, D), DN_BETA * MIX_WIDTH ** -0.5),
        "ln1_g": 1.0 + nrm(ks[8], (L, D), 0.01),
        "ln1_b": nrm(ks[9], (L, D), 0.01),
        "peer_wq": nrm(ks[10], (L, D, PEER_HEADS * PEER_QDIM), D ** -0.5),
        "peer_keys": nrm(ks[11], (L, PEER_HEADS, 2, PEER_NKEYS, PEER_HALF), PEER_HALF ** -0.5),
        "peer_down": nrm(ks[12], (L, PEER_EXPERTS, D), D ** -0.5),
        "peer_up": nrm(ks[13], (L, PEER_EXPERTS, D), DN_BETA),
        "ln2_g": 1.0 + nrm(ks[14], (L, D), 0.01),
        "ln2_b": nrm(ks[15], (L, D), 0.01),
    }


def reference(x, w_in, conv_qkv, a_log, dt_bias, gdn_norm_w, conv_short, w_out,
              ln1_g, ln1_b, peer_wq, peer_keys, peer_down, peer_up, ln2_g, ln2_b):
    for l in range(DEPTH):
        mix = hybrid_mixer(x, w_in[l], conv_qkv[l], a_log[l], dt_bias[l], gdn_norm_w[l],
                           conv_short[l], w_out[l])
        x = layer_norm(DN_ALPHA * x + mix, ln1_g[l], ln1_b[l])
        ffn = peer_ffn(x, peer_wq[l], peer_keys[l], peer_down[l], peer_up[l])
        x = layer_norm(DN_ALPHA * x + ffn, ln2_g[l], ln2_b[l])
    return x
```

```cpp
#include <hip/hip_runtime.h>
#include <hip/hip_cooperative_groups.h>
#include <stdint.h>
#include <cstdio>
namespace cg = cooperative_groups;

namespace cfg {
constexpr int D = 4096, NB = 4, S = 2048, T = NB * S;
constexpr int GH = 16, GD = 128, GW = 2048;
constexpr int NIN = 14368;
constexpr int NP = 14336;
constexpr int Q0 = 0, K0 = 2048, V0 = 4096, Z0 = 6144, BETA0 = 8192, A0 = 8208;
constexpr int PGB0 = 8192, PGC0 = 10240, PH0 = 12288;
constexpr int PH = 8, PK = 16, PN = 128, PQ = 256;
constexpr int NQ = PH * PQ;
constexpr int NE = 16384;
constexpr float ALPHA = 1.189207115002721f;
constexpr float LN_EPS = 1e-5f, RMS_EPS = 1e-6f;
}
using namespace cfg;
namespace pg8 {
#define PG8_LAS __attribute__((address_space(3)))
typedef unsigned short bf16_t;
typedef short bf16x8 __attribute__((ext_vector_type(8)));
typedef float f32x4 __attribute__((ext_vector_type(4)));
typedef unsigned u32x4 __attribute__((ext_vector_type(4)));
constexpr int BM = 256, BK = 64, HALF = 128, HTB = HALF * BK * 2  , STAGE_BYTES = 8 * HTB, NXCD = 8, WGM = 4;

__host__ __device__ __forceinline__ int lds_byte(int r, int c) { const int st = (r >> 4) * 2 + (c >> 5), rr = r & 15, cc = c & 31, ob = rr * 64 + cc * 2; return st * 1024 + (ob ^ (((ob >> 9) & 1) << 5)); }
__host__ __device__ __forceinline__ void stage_rc(int b, int& R, int& C) { const int st = b / 1024, sb = b % 1024, swz = sb ^ (((sb >> 9) & 1) << 5); R = (st >> 1) * 16 + swz / 64; C = (st & 1) * 32 + (swz % 64) / 2; }
__host__ __device__ __forceinline__ int perm32(int rho) { const int n = rho >> 4, i = rho & 15; return 8 * (i >> 2) + 4 * n + (i & 3); }

struct Unit { int pm, pn; };
struct Gemm { const bf16_t* A; const bf16_t* Bt; int M, N, K; };

struct StaticOrder {
    int nM, nN, nwg, G, c;
    __host__ __device__ void init(int M, int N, int G_, int c_) { nM = M / BM; nN = N / BM; nwg = nM * nN; G = G_; c = c_; }
    __host__ __device__ bool next(int i, Unit& u) const {
        const long L = (long)i * G + c; if (L >= nwg) return false;
        int wgid = (int)L; { const int q = nwg / NXCD, r = nwg % NXCD, xcd = wgid % NXCD, off = wgid / NXCD; wgid = (xcd < r ? xcd * (q + 1) : r * (q + 1) + (xcd - r) * q) + off; }
        const int nig = WGM * nN, gid = wgid / nig, fm = gid * WGM, gsz = (nM - fm) < WGM ? (nM - fm) : WGM;
        u.pm = fm + ((wgid % nig) % gsz); u.pn = (wgid % nig) / gsz; return true;
    }
    __device__ __forceinline__ void a_ready(const Unit&) const {}
    __device__ __forceinline__ void done(const Unit&) const {}
};
struct StaticOrderSkip : StaticOrder {
    int s0, sn;
    __host__ __device__ bool next(int i, Unit& u) const { if (!StaticOrder::next(i, u)) return false; if (u.pn >= s0) u.pn += sn; return true; }
};
__device__ __forceinline__ unsigned cvt_pk_bf16(float lo, float hi) { unsigned r; asm volatile("v_cvt_pk_bf16_f32 %0, %1, %2" : "=v"(r) : "v"(lo), "v"(hi)); return r; }
typedef float f32x2 __attribute__((ext_vector_type(2)));
typedef int i32x8 __attribute__((ext_vector_type(8)));
template <class Epi, class Sched, bool ALIGN_EPI = false, bool SP2 = false, bool F8 = false>
__device__ __forceinline__ void gemm_phase(PG8_LAS unsigned char* lds, const Gemm g, const Sched& S, const Epi& E, int tid_in = -1) {
    const int tid = tid_in < 0 ? (int)threadIdx.x : tid_in, wid = __builtin_amdgcn_readfirstlane(tid >> 6), lane = tid & 63, wr = wid >> 2, wc = wid & 3, fr = lane & 15, fq = lane >> 4;
    const int K = F8 ? g.K / 2 : g.K, nt = K / BK;
    unsigned voffA[2], voffB[2];
#pragma unroll
    for (int i = 0; i < 2; ++i) { int R, C; stage_rc(tid * 16 + i * 8192, R, C); const int Rb = Epi::PERM ? ((R & ~31) + perm32(R & 31)) : R;
        voffA[i] = (unsigned)(R * K + C) * 2u; voffB[i] = (unsigned)(Rb * K + C) * 2u; }
    const size_t kstep = (size_t)(BK * 2);
    const size_t hstep = (size_t)HALF * K * 2;
    const size_t tstep = 2 * hstep;
    const unsigned ldsw = (unsigned)wid * 1024u;
    const int aoff = lds_byte(wr * 64 + fr, F8 ? fq * 16 : fq * 8), boff = lds_byte(wc * 32 + fr, F8 ? fq * 16 : fq * 8);
    const int aoff1 = aoff + (F8 ? 16 : 1024), boff1 = boff + (F8 ? 16 : 1024);
#define PG8_SA(b, h) (((b) * 2 + (h)) * HTB)
#define PG8_SB(b, h) ((4 + (b) * 2 + (h)) * HTB)
    const __amdgpu_buffer_rsrc_t rsA = __builtin_amdgcn_make_buffer_rsrc((void*)g.A, 0, 0x7fffffff, 0x00020000), rsB = __builtin_amdgcn_make_buffer_rsrc((void*)g.Bt, 0, 0x7fffffff, 0x00020000);
#define PG8_STAGE(bufoff, gbase, voff) do { const bool isA_ = ((const unsigned*)(voff) == (const unsigned*)voffA); \
        const int so_ = (int)((const char*)(gbase) - (const char*)(isA_ ? (const void*)g.A : (const void*)g.Bt)); \
        _Pragma("unroll") for (int _i = 0; _i < 2; ++_i)        \
        __builtin_amdgcn_raw_ptr_buffer_load_lds(isA_ ? rsA : rsB, (PG8_LAS unsigned*)(lds + (bufoff) + ldsw + _i * 8192), 16, (int)(voff)[0], so_ + _i * 64 * K * 2, 0, 0); } while (0)
#define PG8_LDA(dst, b, h) do { _Pragma("unroll") for (int m = 0; m < 4; ++m) dst[m] = __builtin_shufflevector(*(const PG8_LAS bf16x8*)(lds + PG8_SA(b, h) + aoff + m * 2048), *(const PG8_LAS bf16x8*)(lds + PG8_SA(b, h) + aoff1 + m * 2048), 0, 1, 2, 3, 4, 5, 6, 7, 8, 9, 10, 11, 12, 13, 14, 15); } while (0)
#define PG8_LDB(dst, b, h) do { _Pragma("unroll") for (int n = 0; n < 2; ++n) dst[n] = __builtin_shufflevector(*(const PG8_LAS bf16x8*)(lds + PG8_SB(b, h) + boff + n * 2048), *(const PG8_LAS bf16x8*)(lds + PG8_SB(b, h) + boff1 + n * 2048), 0, 1, 2, 3, 4, 5, 6, 7, 8, 9, 10, 11, 12, 13, 14, 15); } while (0)
#define PG8_MMA(ai, bj, At, Bt) do { __builtin_amdgcn_s_setprio(1); _Pragma("unroll") for (int m = 0; m < 4; ++m) _Pragma("unroll") for (int n = 0; n < 2; ++n) { \
        if constexpr (F8) { \
            acc[ai][bj][m][n] = __builtin_amdgcn_mfma_scale_f32_16x16x128_f8f6f4(__builtin_bit_cast(i32x8, Bt[n]), __builtin_bit_cast(i32x8, At[m]), acc[ai][bj][m][n], 0, 0, 0, 0x7f7f7f7f, 0, 0x7f7f7f7f); \
        } else { \
            acc[ai][bj][m][n] = __builtin_amdgcn_mfma_f32_16x16x32_bf16(__builtin_shufflevector(Bt[n], Bt[n], 0, 1, 2, 3, 4, 5, 6, 7), __builtin_shufflevector(At[m], At[m], 0, 1, 2, 3, 4, 5, 6, 7), acc[ai][bj][m][n], 0, 0, 0); \
            acc[ai][bj][m][n] = __builtin_amdgcn_mfma_f32_16x16x32_bf16(__builtin_shufflevector(Bt[n], Bt[n], 8, 9, 10, 11, 12, 13, 14, 15), __builtin_shufflevector(At[m], At[m], 8, 9, 10, 11, 12, 13, 14, 15), acc[ai][bj][m][n], 0, 0, 0); } } \
        __builtin_amdgcn_s_setprio(0); } while (0)
#define PG8_WAIT_V(n) asm volatile("s_waitcnt vmcnt(" #n ")" ::: "memory")
#define PG8_WAIT_L(n) asm volatile("s_waitcnt lgkmcnt(" #n ")" ::: "memory")
#define PG8_BAR __builtin_amdgcn_s_barrier()
#define PG8_SCHED __builtin_amdgcn_sched_barrier(0)
    Unit cur, nxt; int ui = 0;
    if (!S.next(0, cur)) return;
    f32x4 acc[2][2][4][2];
#pragma unroll
    for (int a = 0; a < 2; ++a)
#pragma unroll
        for (int b = 0; b < 2; ++b)
#pragma unroll
            for (int m = 0; m < 4; ++m)
#pragma unroll
                for (int n = 0; n < 2; ++n) acc[a][b][m][n] = (f32x4){0.f, 0.f, 0.f, 0.f};
    typedef short s16x16 __attribute__((ext_vector_type(16)));
    s16x16 At[4], B0[2], B1[2];
    const char* cA = (const char*)g.A + (size_t)cur.pm * tstep; const char* cB = (const char*)g.Bt + (size_t)cur.pn * tstep;
    S.a_ready(cur);
    if constexpr (SP2) {
        PG8_STAGE(PG8_SB(0, 0), cB, voffB); PG8_STAGE(PG8_SB(0, 1), cB + hstep, voffB); PG8_STAGE(PG8_SA(0, 0), cA, voffA); PG8_STAGE(PG8_SA(0, 1), cA + hstep, voffA);
        if (wr == 1) PG8_BAR;
        PG8_WAIT_V(2); PG8_BAR;
        PG8_STAGE(PG8_SB(1, 0), cB + kstep, voffB); PG8_STAGE(PG8_SA(1, 0), cA + kstep, voffA); PG8_STAGE(PG8_SB(1, 1), cB + hstep + kstep, voffB);
        PG8_WAIT_V(6); PG8_BAR;
    } else {
        PG8_STAGE(PG8_SB(0, 0), cB, voffB); PG8_STAGE(PG8_SA(0, 0), cA, voffA); PG8_STAGE(PG8_SB(0, 1), cB + hstep, voffB); PG8_STAGE(PG8_SA(0, 1), cA + hstep, voffA);
        if (wr == 1) PG8_BAR;
        PG8_WAIT_V(4); PG8_BAR;
        PG8_STAGE(PG8_SB(1, 0), cB + kstep, voffB); PG8_STAGE(PG8_SA(1, 0), cA + kstep, voffA); PG8_STAGE(PG8_SB(1, 1), cB + hstep + kstep, voffB);
        PG8_WAIT_V(6); PG8_BAR;
    }
    for (;;) {
        const bool has_next = S.next(ui + 1, nxt);
        const char* nA = has_next ? (const char*)g.A + (size_t)nxt.pm * tstep : cA; const char* nB = has_next ? (const char*)g.Bt + (size_t)nxt.pn * tstep : cB;
        for (int t = 0; t < nt; t += 2) {
            const bool last = (t == nt - 2);
            const char* a1 = cA + (size_t)(t + 1) * kstep;
            const char* a2 = last ? nA : cA + (size_t)(t + 2) * kstep; const char* b2 = last ? nB : cB + (size_t)(t + 2) * kstep;
            const char* a3 = a2 + kstep; const char* b3 = b2 + kstep;
            if (last && has_next) S.a_ready(nxt);
            if constexpr (SP2) {
            PG8_LDB(B0, 0, 0); PG8_LDB(B1, 0, 1); PG8_SCHED; PG8_LDA(At, 0, 0); PG8_STAGE(PG8_SA(1, 1), a1 + hstep, voffA);
            PG8_WAIT_V(8); PG8_WAIT_L(0); PG8_BAR; PG8_MMA(0, 0, At, B0); PG8_MMA(0, 1, At, B1); PG8_BAR; PG8_SCHED;
            PG8_LDA(At, 0, 1); PG8_STAGE(PG8_SB(0, 0), b2, voffB); PG8_STAGE(PG8_SB(0, 1), b2 + hstep, voffB); PG8_STAGE(PG8_SA(0, 0), a2, voffA);
            PG8_WAIT_V(8); PG8_WAIT_L(0); PG8_BAR; PG8_MMA(1, 0, At, B0); PG8_MMA(1, 1, At, B1); PG8_BAR; PG8_SCHED;
            PG8_LDB(B0, 1, 0); PG8_LDB(B1, 1, 1); PG8_SCHED; PG8_LDA(At, 1, 0); PG8_STAGE(PG8_SA(0, 1), a2 + hstep, voffA);
            PG8_WAIT_V(8); PG8_WAIT_L(0); PG8_BAR; PG8_MMA(0, 0, At, B0); PG8_MMA(0, 1, At, B1); PG8_BAR; PG8_SCHED;
            PG8_LDA(At, 1, 1); PG8_STAGE(PG8_SB(1, 0), b3, voffB); PG8_STAGE(PG8_SB(1, 1), b3 + hstep, voffB); PG8_STAGE(PG8_SA(1, 0), a3, voffA);
            PG8_WAIT_V(8); PG8_WAIT_L(0); PG8_BAR; PG8_MMA(1, 0, At, B0); PG8_MMA(1, 1, At, B1); PG8_BAR; PG8_SCHED;
            } else {
            PG8_LDB(B0, 0, 0); PG8_SCHED; PG8_LDA(At, 0, 0); PG8_STAGE(PG8_SA(1, 1), a1 + hstep, voffA);
            PG8_WAIT_L(8); PG8_BAR; PG8_WAIT_L(0); PG8_MMA(0, 0, At, B0); PG8_BAR; PG8_SCHED;
            PG8_LDB(B1, 0, 1); PG8_STAGE(PG8_SB(0, 0), b2, voffB);
            PG8_BAR; PG8_WAIT_L(0); PG8_MMA(0, 1, At, B1); PG8_BAR;
            PG8_LDA(At, 0, 1); PG8_STAGE(PG8_SA(0, 0), a2, voffA);
            PG8_BAR; PG8_WAIT_L(0); PG8_MMA(1, 0, At, B0); PG8_BAR; PG8_SCHED;
            PG8_STAGE(PG8_SB(0, 1), b2 + hstep, voffB);
            PG8_WAIT_V(6); PG8_BAR; PG8_MMA(1, 1, At, B1); PG8_BAR;
            PG8_LDB(B0, 1, 0); PG8_SCHED; PG8_LDA(At, 1, 0); PG8_STAGE(PG8_SA(0, 1), a2 + hstep, voffA);
            PG8_WAIT_L(8); PG8_BAR; PG8_WAIT_L(0); PG8_MMA(0, 0, At, B0); PG8_BAR; PG8_SCHED;
            PG8_LDB(B1, 1, 1); PG8_STAGE(PG8_SB(1, 0), b3, voffB);
            PG8_BAR; PG8_WAIT_L(0); PG8_MMA(0, 1, At, B1); PG8_BAR;
            PG8_LDA(At, 1, 1); PG8_STAGE(PG8_SA(1, 0), a3, voffA);
            PG8_BAR; PG8_WAIT_L(0); PG8_MMA(1, 0, At, B0); PG8_BAR; PG8_SCHED;
            PG8_STAGE(PG8_SB(1, 1), b3 + hstep, voffB);
            PG8_WAIT_V(6); PG8_BAR; PG8_MMA(1, 1, At, B1); PG8_BAR;
            }
        }
        if constexpr (ALIGN_EPI) { if (wr == 0) PG8_BAR; }
        if constexpr (!Epi::AFTER_DRAIN) { E(acc, cur, wr, wc, fr, fq); S.done(cur); }
        if (!has_next) break;
#pragma unroll
        for (int a = 0; a < 2; ++a)
#pragma unroll
            for (int b = 0; b < 2; ++b)
#pragma unroll
                for (int m = 0; m < 4; ++m)
#pragma unroll
                    for (int n = 0; n < 2; ++n) acc[a][b][m][n] = (f32x4){0.f, 0.f, 0.f, 0.f};
        cur = nxt; cA = nA; cB = nB; ++ui;
        if constexpr (ALIGN_EPI) { if (wr == 1) PG8_BAR; }
    }
    PG8_WAIT_V(0);
    if constexpr (!ALIGN_EPI) { if (wr == 0) PG8_BAR; }
    PG8_BAR;
    if constexpr (Epi::AFTER_DRAIN) { E.fused(acc, cur, wr, wc, fr, fq, lds, wid, lane); S.done(cur); }
#undef PG8_SA
#undef PG8_SB
#undef PG8_STAGE
#undef PG8_LDA
#undef PG8_LDB
#undef PG8_MMA
#undef PG8_WAIT_V
#undef PG8_WAIT_L
#undef PG8_BAR
#undef PG8_SCHED
}
}

#define LAS __attribute__((address_space(3)))
typedef unsigned short bf16;
typedef unsigned v4u __attribute__((ext_vector_type(4)));
typedef float f32x4 __attribute__((ext_vector_type(4)));
typedef float f32x16 __attribute__((ext_vector_type(16)));
typedef short bf16x8 __attribute__((ext_vector_type(8)));
typedef float f32x2v __attribute__((ext_vector_type(2)));
#define LDS_WAIT() asm volatile("s_waitcnt lgkmcnt(0)" ::: "memory")
#define VM_WAIT() asm volatile("s_waitcnt vmcnt(0)" ::: "memory")
__device__ __forceinline__ unsigned f2bf(float f) { unsigned u = __builtin_bit_cast(unsigned, f); return (u + 0x7fffu + ((u >> 16) & 1u)) >> 16; }
__device__ __forceinline__ unsigned pk2(float lo, float hi) { return f2bf(lo) | (f2bf(hi) << 16); }
__device__ __forceinline__ float clamp448(float v) { return fminf(fmaxf(v, -448.f), 448.f); }
__device__ __forceinline__ unsigned pk4_fp8(float a0, float a1, float a2, float a3) { int p = 0; p = __builtin_amdgcn_cvt_pk_fp8_f32(clamp448(a0), clamp448(a1), p, false); p = __builtin_amdgcn_cvt_pk_fp8_f32(clamp448(a2), clamp448(a3), p, true); return (unsigned)p; }
__device__ __forceinline__ float bf2f(unsigned short b) { return __builtin_bit_cast(float, (unsigned)b << 16); }
__device__ __forceinline__ float bflo(unsigned w) { return __builtin_bit_cast(float, w << 16); }
__device__ __forceinline__ float bfhi(unsigned w) { return __builtin_bit_cast(float, w & 0xffff0000u); }

__device__ __forceinline__ float wave_sum(float v) {
#pragma unroll
    for (int o = 1; o < 64; o <<= 1) v += __shfl_xor(v, o);
    return v;
}
__device__ __forceinline__ float silu_f(float x) { return x * __builtin_amdgcn_rcpf(1.f + __expf(-x)); }
__device__ __forceinline__ float sigmoid_f(float x) { return 1.f / (1.f + expf(-x)); }
__device__ __forceinline__ float softplus_f(float x) { return x > 20.f ? x : log1pf(expf(x)); }
__device__ __forceinline__ float gelu_f(float z) { return 0.5f * z * (1.f + erff(z * 0.7071067811865476f)); }

constexpr size_t al256(size_t x) { return (x + 255) & ~(size_t)255; }
constexpr size_t WS_CTL = 0;
constexpr size_t CTL_WIMAX = 65536;
constexpr size_t CTL_WOMAX = 32768;
constexpr size_t CTL_TBLQ = 126976;
constexpr size_t CTL_BYTES = 131072;
constexpr size_t WS_XB = WS_CTL + CTL_BYTES;
constexpr size_t WS_WIN = WS_XB + al256((size_t)T * D * 2);
constexpr size_t WS_WOUT = WS_WIN + al256((size_t)NP * D * 2);
constexpr size_t WS_WQ = WS_WOUT + al256((size_t)D * D * 2);
constexpr size_t WS_BRAW = WS_WQ + al256((size_t)NQ * D * 2);
constexpr size_t WS_PROJ = WS_BRAW + al256((size_t)T * 32 * 4);
constexpr size_t WS_CAT = WS_PROJ + al256((size_t)T * NP * 2);
constexpr size_t WS_PRE1 = WS_CAT + al256((size_t)T * D * 2);
constexpr size_t WS_X1 = WS_PRE1 + al256((size_t)T * D * 4);
constexpr int F8G0 = 0, F8G1 = 7;
constexpr int F8C0 = F8G0 * 2048, F8C1 = F8G1 * 2048, F8N = F8C1 - F8C0;
constexpr float XQ_SCALE = 16.f;
constexpr size_t WS_XQ8 = WS_X1;
constexpr size_t WS_WIN8 = WS_XQ8 + al256((size_t)T * D);
constexpr size_t WS_SWIN = WS_WIN8 + al256((size_t)F8N * D);
static_assert(WS_SWIN + F8N * 4 <= WS_X1 + (size_t)T * D * 4, "fp8 in-projection operands must fit in the X1 region");
constexpr size_t WS_ETAB_IN = WS_WIN;
constexpr size_t WS_ETAB_OUT = WS_ETAB_IN + al256((size_t)NP * 64);
static_assert(F8G0 == 0 && F8G1 == 7, "the fp8 transposes cover the whole in-projection");
constexpr size_t WS_X1B = WS_X1 + al256((size_t)T * D * 4);
constexpr size_t WS_QPB = WS_X1B + al256((size_t)T * D * 2);
constexpr size_t WS_KEYSB = WS_QPB + al256((size_t)T * NQ * 2);
constexpr size_t WS_EIDX = WS_KEYSB + al256((size_t)PH * 2 * PN * 128 * 2);
constexpr size_t WS_EGATE = WS_EIDX + al256((size_t)T * PH * PK * 4);
constexpr size_t WS_WD8 = WS_EGATE + al256((size_t)T * PH * PK * 4);
constexpr size_t WS_WU8 = WS_WD8 + al256((size_t)NE * D);
constexpr size_t WS_SD = WS_WU8 + al256((size_t)NE * D);
constexpr size_t WS_SU = WS_SD + al256((size_t)NE * 4);
constexpr size_t WS_WOUT8 = WS_SU + al256((size_t)NE * 4);
constexpr size_t WS_SWOUT = WS_WOUT8 + al256((size_t)D * D);
constexpr size_t WS_ABUF = WS_SWOUT + al256((size_t)D * 4);
constexpr size_t WS_END = WS_ABUF + al256((size_t)T * 128 * 4);
static_assert(WS_END <= (size_t)1024 * 1024 * 1024, "workspace");

constexpr int NWAVES = 8, NTHREADS = 512;
constexpr int TBL_GROUPS = 2 * NE / 8;
constexpr int LDS_BYTES = 147456;

struct EpiBf16 {
    static constexpr bool PERM = true, AFTER_DRAIN = false;
    bf16* O; int ldc;
    __device__ __forceinline__ void operator()(const pg8::f32x4 (&acc)[2][2][4][2], const pg8::Unit& u, int wr, int wc, int fr, int fq) const {
        const int row0 = u.pm * 256 + wr * 64 + fr, col0 = u.pn * 256 + wc * 32 + 8 * fq;
#pragma unroll
        for (int ai = 0; ai < 2; ++ai)
#pragma unroll
            for (int m = 0; m < 4; ++m) { bf16* rowp = O + (size_t)(row0 + ai * 128 + m * 16) * ldc + col0;
#pragma unroll
                for (int bj = 0; bj < 2; ++bj) { const pg8::f32x4 v0 = acc[ai][bj][m][0], v1 = acc[ai][bj][m][1];
                    pg8::u32x4 w; w.x = pg8::cvt_pk_bf16(v0[0], v0[1]); w.y = pg8::cvt_pk_bf16(v0[2], v0[3]); w.z = pg8::cvt_pk_bf16(v1[0], v1[1]); w.w = pg8::cvt_pk_bf16(v1[2], v1[3]);
                    *(pg8::u32x4*)(rowp + bj * 128) = w; } }
    }
};
struct EpiBf16Res {
    static constexpr bool PERM = false, AFTER_DRAIN = false;
    bf16* C; const float* R; int ldc; float alpha; const float* cs;
    __device__ __forceinline__ void operator()(const pg8::f32x4 (&acc)[2][2][4][2], const pg8::Unit& u, int wr, int wc, int fr, int fq) const {
        { int ln; asm volatile("v_mbcnt_lo_u32_b32 %0, -1, 0\n\tv_mbcnt_hi_u32_b32 %0, -1, %0" : "=v"(ln)); fr = ln & 15; fq = ln >> 4; }
        const int row0 = u.pm * 256 + wr * 64 + fr, col0 = u.pn * 256 + wc * 32 + 4 * fq;
#pragma unroll
        for (int ai = 0; ai < 2; ++ai)
#pragma unroll
            for (int m = 0; m < 4; ++m) { const size_t ro = (size_t)(row0 + ai * 128 + m * 16) * ldc + col0;
#pragma unroll
                for (int bj = 0; bj < 2; ++bj)
#pragma unroll
                    for (int n = 0; n < 2; ++n) { const size_t o = ro + bj * 128 + n * 16;
                        pg8::f32x4 v = acc[ai][bj][m][n];
                        if (cs) v = v * *(const pg8::f32x4*)(cs + col0 + bj * 128 + n * 16);
                        if (R) v = v + *(const pg8::f32x4*)(R + o) * alpha;
                        *(unsigned long long*)(C + o) = (unsigned long long)pg8::cvt_pk_bf16(v[0], v[1]) | ((unsigned long long)pg8::cvt_pk_bf16(v[2], v[3]) << 32); }
                asm volatile("" ::: "memory"); }
    }
};

__device__ __forceinline__ void p0_transpose_item(const float* __restrict__ W, int N, int K, int k0, int n0, bf16* WT, int drow0, LAS float* scr, int lane, unsigned* rmax = nullptr) {
#pragma unroll 8
    for (int i = 0; i < 32; ++i) { const int kk = 2 * i + (lane >> 5); scr[kk * 33 + (lane & 31)] = W[(size_t)(k0 + kk) * N + n0 + (lane & 31)]; }
    LDS_WAIT(); asm volatile("" ::: "memory");
    const int c = lane & 7;
#pragma unroll
    for (int j = 0; j < 4; ++j) { const int n = (lane >> 3) + 8 * j; const LAS float* s = scr + (8 * c) * 33 + n;
        v4u o; o.x = pk2(s[0 * 33], s[1 * 33]); o.y = pk2(s[2 * 33], s[3 * 33]); o.z = pk2(s[4 * 33], s[5 * 33]); o.w = pk2(s[6 * 33], s[7 * 33]);
        *(v4u*)(WT + (size_t)(drow0 + n) * K + k0 + 8 * c) = o;
        if (rmax) {
            float mx = fmaxf(fmaxf(fmaxf(fabsf(s[0 * 33]), fabsf(s[1 * 33])), fmaxf(fabsf(s[2 * 33]), fabsf(s[3 * 33]))), fmaxf(fmaxf(fabsf(s[4 * 33]), fabsf(s[5 * 33])), fmaxf(fabsf(s[6 * 33]), fabsf(s[7 * 33]))));
            mx = fmaxf(mx, __shfl_xor(mx, 1)); mx = fmaxf(mx, __shfl_xor(mx, 2)); mx = fmaxf(mx, __shfl_xor(mx, 4));
            if (c == 0) atomicMax(rmax + drow0 + n, __builtin_bit_cast(unsigned, mx)); } }
    LDS_WAIT(); asm volatile("" ::: "memory");
}

__device__ __forceinline__ void p0_transpose_item_f8(const float* __restrict__ W, int N, int K, int k0, int n0, unsigned char* W8T, int drow0, LAS float* scr, int lane, unsigned* rmax, signed char* etab) {
#pragma unroll 8
    for (int i = 0; i < 32; ++i) { const int kk = 2 * i + (lane >> 5); scr[kk * 33 + (lane & 31)] = W[(size_t)(k0 + kk) * N + n0 + (lane & 31)]; }
    LDS_WAIT(); asm volatile("" ::: "memory");
    const int c = lane & 7;
#pragma unroll
    for (int j = 0; j < 4; ++j) { const int n = (lane >> 3) + 8 * j; const LAS float* s = scr + (8 * c) * 33 + n;
        float v[8];
#pragma unroll
        for (int i = 0; i < 8; ++i) v[i] = s[i * 33];
        float mx = fmaxf(fmaxf(fmaxf(fabsf(v[0]), fabsf(v[1])), fmaxf(fabsf(v[2]), fabsf(v[3]))), fmaxf(fmaxf(fabsf(v[4]), fabsf(v[5])), fmaxf(fabsf(v[6]), fabsf(v[7]))));
        mx = fmaxf(mx, __shfl_xor(mx, 1)); mx = fmaxf(mx, __shfl_xor(mx, 2)); mx = fmaxf(mx, __shfl_xor(mx, 4));
        const int e = mx > 0.f ? min(max(__builtin_amdgcn_frexp_expf(mx * (1.f / 448.f)), -100), 100) : -100;
        const float sc = __builtin_amdgcn_ldexpf(1.f, -e);
        *(unsigned long long*)(W8T + (size_t)(drow0 + n) * K + k0 + 8 * c) = (unsigned long long)pk4_fp8(v[0] * sc, v[1] * sc, v[2] * sc, v[3] * sc) | ((unsigned long long)pk4_fp8(v[4] * sc, v[5] * sc, v[6] * sc, v[7] * sc) << 32);
        if (c == 0) { etab[(size_t)(drow0 + n) * (K / 64) + (k0 >> 6)] = (signed char)e; atomicMax(rmax + drow0 + n, __builtin_bit_cast(unsigned, mx)); } }
    LDS_WAIT(); asm volatile("" ::: "memory");
}
__device__ __forceinline__ void rescale_rows_fp8(unsigned char* w8, const signed char* etab, float* sw, const unsigned* rmax, int nrows, float post, int lane, int wave) {
    for (int n = blockIdx.x * NWAVES + wave; n < nrows; n += gridDim.x * NWAVES) {
        const float m = __builtin_bit_cast(float, rmax[n]);
        const int er = m > 0.f ? min(max(__builtin_amdgcn_frexp_expf(m * (1.f / 448.f)), -100), 100) : -100;
        const int sh = er - (int)etab[(size_t)n * 64 + lane];
        if (sh > 0) {
            const float f = __builtin_amdgcn_ldexpf(1.f, -sh);
            v4u* p = (v4u*)(w8 + (size_t)n * D + 64 * lane);
#pragma unroll
            for (int q = 0; q < 4; ++q) { v4u t = p[q];
#pragma unroll
                for (int d = 0; d < 4; ++d) { const f32x2v lo = __builtin_amdgcn_cvt_pk_f32_fp8((int)t[d], false), hi = __builtin_amdgcn_cvt_pk_f32_fp8((int)t[d], true);
                    int o = 0; o = __builtin_amdgcn_cvt_pk_fp8_f32(lo[0] * f, lo[1] * f, o, false); o = __builtin_amdgcn_cvt_pk_fp8_f32(hi[0] * f, hi[1] * f, o, true); t[d] = (unsigned)o; }
                p[q] = t; }
        }
        if (lane == 0) sw[n] = __builtin_amdgcn_ldexpf(1.f, er) * post;
    }
}

__device__ __forceinline__ void quant_rows_fp8(const bf16* wt, unsigned char* w8, float* sw, const unsigned* rmax, int nrows, float post, int lane, int wave) {
    for (int n = blockIdx.x * NWAVES + wave; n < nrows; n += gridDim.x * NWAVES) {
        const float m = __builtin_bit_cast(float, rmax[n]); const float inv = m > 0.f ? 448.f / m : 0.f;
#pragma unroll
        for (int j = 0; j < 4; ++j) {
            const bf16* src = wt + (size_t)n * D + 1024 * j + 16 * lane;
            const v4u a0 = *(const v4u*)src, a1 = *(const v4u*)(src + 8);
            v4u o; o.x = pk4_fp8(bflo(a0.x) * inv, bfhi(a0.x) * inv, bflo(a0.y) * inv, bfhi(a0.y) * inv); o.y = pk4_fp8(bflo(a0.z) * inv, bfhi(a0.z) * inv, bflo(a0.w) * inv, bfhi(a0.w) * inv);
            o.z = pk4_fp8(bflo(a1.x) * inv, bfhi(a1.x) * inv, bflo(a1.y) * inv, bfhi(a1.y) * inv); o.w = pk4_fp8(bflo(a1.z) * inv, bfhi(a1.z) * inv, bflo(a1.w) * inv, bfhi(a1.w) * inv);
            *(v4u*)(w8 + (size_t)n * D + 1024 * j + 16 * lane) = o;
        }
        if (lane == 0) sw[n] = m * (1.f / 448.f) * post;
    }
}

struct Args { const float* in[16]; float* out; unsigned char* ws; int ph_lo, ph_hi; };

__device__ __forceinline__ void phase0(const Args& a, LAS unsigned char* lds, int tid, int lane, int wave) {
    const float* x = a.in[0]; const float* w_in = a.in[1]; const float* w_out = a.in[7]; const float* wq = a.in[10];
    unsigned char* ws = a.ws;
    bf16* xb = (bf16*)(ws + WS_XB); bf16* win_t = (bf16*)(ws + WS_WIN); bf16* wout_t = (bf16*)(ws + WS_WOUT); bf16* wq_t = (bf16*)(ws + WS_WQ);
    float* braw = (float*)(ws + WS_BRAW);
    const int G = gridDim.x, gw = blockIdx.x * NWAVES + wave, NGW = G * NWAVES;
    for (int tt = blockIdx.x; tt < T / 32; tt += G) {
        const int t0 = tt * 32;
        f32x16 acc;
#pragma unroll
        for (int i = 0; i < 16; ++i) acc[i] = 0.f;
        const float* xa = x + (size_t)(t0 + (lane & 31)) * D + 512 * wave + 4 * (lane >> 5);
        const float* wb = w_in + (size_t)(512 * wave + 4 * (lane >> 5)) * NIN + BETA0 + (lane & 31);
        unsigned char* xq = ws + WS_XQ8 + (size_t)(t0 + (lane & 31)) * D + 512 * wave + 8 * (lane >> 5);
#pragma unroll 8
        for (int j2 = 0; j2 < 32; ++j2) {
            unsigned q8[2];
#pragma unroll
            for (int jj = 0; jj < 2; ++jj) { const int j = 2 * j2 + jj;
                const f32x4 v = *(const f32x4*)(xa + 8 * j);
                float b[4];
#pragma unroll
                for (int c = 0; c < 4; ++c) b[c] = wb[(size_t)(8 * j + c) * NIN];
                q8[jj] = pk4_fp8(v[0] * XQ_SCALE, v[1] * XQ_SCALE, v[2] * XQ_SCALE, v[3] * XQ_SCALE);
#pragma unroll
                for (int c = 0; c < 4; ++c) acc = __builtin_amdgcn_mfma_f32_32x32x2f32(v[c], b[c], acc, 0, 0, 0);
            }
            const auto sw = __builtin_amdgcn_permlane32_swap(q8[0], q8[1], false, false);
            *(unsigned long long*)(xq + 16 * j2) = (unsigned long long)sw[0] | ((unsigned long long)sw[1] << 32);
        }
        LAS float* part = (LAS float*)lds;
#pragma unroll
        for (int r = 0; r < 16; ++r) part[(wave * 16 + r) * 64 + lane] = acc[r];
        __syncthreads();
        for (int e = tid; e < 1024; e += NTHREADS) {
            float s = 0.f;
#pragma unroll
            for (int w = 0; w < 8; ++w) s += part[w * 1024 + e];
            const int r = e >> 6, l = e & 63;
            const int row = (r & 3) + 8 * (r >> 2) + 4 * (l >> 5), col = l & 31;
            braw[(size_t)(t0 + row) * 32 + col] = s;
        }
        __syncthreads();
    }
    {
        const float* keys = a.in[11]; bf16* keysb = (bf16*)(ws + WS_KEYSB);
        const size_t n8 = (size_t)PH * 2 * PN * 128 / 8;
        for (size_t i = (size_t)blockIdx.x * NTHREADS + tid; i < n8; i += (size_t)G * NTHREADS) {
            const f32x4 v0 = *(const f32x4*)(keys + i * 8), v1 = *(const f32x4*)(keys + i * 8 + 4);
            v4u o; o.x = pk2(v0[0], v0[1]); o.y = pk2(v0[2], v0[3]); o.z = pk2(v1[0], v1[1]); o.w = pk2(v1[2], v1[3]);
            *(v4u*)(keysb + i * 8) = o;
        }
    }
    {
        LAS float* scr = (LAS float*)(lds + wave * 16384);
        constexpr int NB_IN = NIN / 32;
        constexpr int I_IN = (D / 64) * NB_IN, I_OUT = (D / 64) * (D / 32), I_Q = (D / 64) * (NQ / 32);
        for (int it = gw; it < I_IN + I_OUT + I_Q; it += NGW) {
            int r = it;
            if (r < I_IN) { const int kb = r / NB_IN, nb = r % NB_IN; if (nb == 256) continue;
                p0_transpose_item_f8(w_in, NIN, D, 64 * kb, 32 * nb, ws + WS_WIN8, 32 * (nb > 256 ? nb - 1 : nb), scr, lane, (unsigned*)(ws + WS_CTL + CTL_WIMAX), (signed char*)(ws + WS_ETAB_IN)); continue; }
            r -= I_IN;
            if (r < I_OUT) { const int kb = r / (D / 32), nb = r % (D / 32); p0_transpose_item_f8(w_out, D, D, 64 * kb, 32 * nb, ws + WS_WOUT8, 32 * nb, scr, lane, (unsigned*)(ws + WS_CTL + CTL_WOMAX), (signed char*)(ws + WS_ETAB_OUT)); continue; }
            r -= I_OUT;
            { const int kb = r / (NQ / 32), nb = r % (NQ / 32); p0_transpose_item(wq, NQ, D, 64 * kb, 32 * nb, wq_t, 32 * nb, scr, lane); }
        }
    }
    __syncthreads();
}

__device__ __forceinline__ void phase_ln1(const Args& a, int lane, int wave) {
    const bf16* pre = (const bf16*)(a.ws + WS_PRE1); bf16* x1b = (bf16*)(a.ws + WS_X1B);
    const float* g = a.in[8]; const float* bb = a.in[9];
    const int gw = blockIdx.x * NWAVES + wave, NGW = gridDim.x * NWAVES;
    for (int m = gw; m < T; m += NGW) {
        const v4u* xr = (const v4u*)(pre + (size_t)m * D) + lane;
        v4u raw[8]; f32x4 v[16]; float s = 0.f;
#pragma unroll
        for (int j = 0; j < 8; ++j) raw[j] = __builtin_nontemporal_load(xr + 64 * j);
#pragma unroll
        for (int j = 0; j < 8; ++j) { v[2 * j] = (f32x4){bflo(raw[j].x), bfhi(raw[j].x), bflo(raw[j].y), bfhi(raw[j].y)}; v[2 * j + 1] = (f32x4){bflo(raw[j].z), bfhi(raw[j].z), bflo(raw[j].w), bfhi(raw[j].w)};
            s += ((v[2 * j][0] + v[2 * j][1]) + (v[2 * j][2] + v[2 * j][3])) + ((v[2 * j + 1][0] + v[2 * j + 1][1]) + (v[2 * j + 1][2] + v[2 * j + 1][3])); }
        const float mean = wave_sum(s) * (1.f / D); float s2 = 0.f;
#pragma unroll
        for (int j = 0; j < 16; ++j) { v[j] = v[j] - mean; s2 += (v[j][0] * v[j][0] + v[j][1] * v[j][1]) + (v[j][2] * v[j][2] + v[j][3] * v[j][3]); }
        const float rstd = rsqrtf(wave_sum(s2) * (1.f / D) + LN_EPS);
#pragma unroll
        for (int j = 0; j < 8; ++j) {
            const int c = (lane + 64 * j) * 8;
            const f32x4 g0 = *(const f32x4*)(g + c), g1 = *(const f32x4*)(g + c + 4), b0 = *(const f32x4*)(bb + c), b1 = *(const f32x4*)(bb + c + 4);
            const f32x4 o0 = v[2 * j] * rstd * g0 + b0, o1 = v[2 * j + 1] * rstd * g1 + b1;
            v4u o; o.x = pk2(o0[0], o0[1]); o.y = pk2(o0[2], o0[3]); o.z = pk2(o1[0], o1[1]); o.w = pk2(o1[2], o1[3]);
            *(v4u*)(x1b + (size_t)m * D + c) = o;
        }
    }
}


typedef __bf16 bf2_t __attribute__((ext_vector_type(2)));
typedef float f2_t __attribute__((ext_vector_type(2)));
__device__ __forceinline__ unsigned pkbf(float lo, float hi) { f2_t v = {lo, hi}; return __builtin_bit_cast(unsigned, __builtin_convertvector(v, bf2_t)); }
__device__ __forceinline__ int f2ord(float f) { const int i = __builtin_bit_cast(int, f); return i ^ ((i >> 31) & 0x7fffffff); }
__device__ __forceinline__ float ord2f(int i) { return __builtin_bit_cast(float, i ^ ((i >> 31) & 0x7fffffff)); }
__device__ __forceinline__ int imax(int a, int b) { return a > b ? a : b; }
__device__ __forceinline__ int imin(int a, int b) { return a < b ? a : b; }
template <int O, int N>
__device__ __forceinline__ void bitonic_sort16(int (&v)[N]) {
#pragma unroll
    for (int k = 2; k <= 16; k <<= 1)
#pragma unroll
        for (int j = k >> 1; j > 0; j >>= 1)
#pragma unroll
            for (int i = 0; i < 16; ++i) {
                const int l = i ^ j;
                if (l > i) {
                    const int a = v[O + i], b = v[O + l], mx = imax(a, b), mn = imin(a, b);
                    if ((i & k) == 0) { v[O + i] = mx; v[O + l] = mn; } else { v[O + i] = mn; v[O + l] = mx; }
                }
            }
}
__device__ __forceinline__ void bitonic_merge16(int (&v)[16]) {
#pragma unroll
    for (int j = 8; j > 0; j >>= 1)
#pragma unroll
        for (int i = 0; i < 16; ++i) {
            const int l = i ^ j;
            if (l > i) { const int a = v[i], b = v[l]; v[i] = imax(a, b); v[l] = imin(a, b); }
        }
}
__device__ __forceinline__ void top16_of_64(int (&v)[64], int (&out)[16]) {
    bitonic_sort16<0>(v); bitonic_sort16<16>(v); bitonic_sort16<32>(v); bitonic_sort16<48>(v);
    int a[16], b[16];
#pragma unroll
    for (int i = 0; i < 16; ++i) { a[i] = imax(v[i], v[31 - i]); b[i] = imax(v[32 + i], v[63 - i]); }
    bitonic_merge16(a); bitonic_merge16(b);
#pragma unroll
    for (int i = 0; i < 16; ++i) out[i] = imax(a[i], b[15 - i]);
    bitonic_merge16(out);
}
__device__ __forceinline__ int sel4(int d0, int d1, int d2, int d3, int q) { const int lo = (q & 1) ? d1 : d0, hi = (q & 1) ? d3 : d2; return (q & 2) ? hi : lo; }


__device__ __forceinline__ void route_scores(const bf16* qpb, const bf16* keysb, int t0, int h, int p, int r, int hh, int (&M)[16]) {
    f32x16 acc[4];
#pragma unroll
    for (int nb = 0; nb < 4; ++nb)
#pragma unroll
        for (int i = 0; i < 16; ++i) acc[nb][i] = 0.f;
    const bf16* qrow = qpb + (size_t)(t0 + r) * NQ + h * PQ + p * 128 + 8 * hh;
    const bf16* krow = keysb + ((size_t)(h * 2 + p) * PN + r) * 128 + 8 * hh;
#pragma unroll 2
    for (int s = 0; s < 8; ++s) {
        const bf16x8 qf = *(const bf16x8*)(qrow + 16 * s);
#pragma unroll
        for (int nb = 0; nb < 4; ++nb) {
            const bf16x8 kf = *(const bf16x8*)(krow + (size_t)(32 * nb) * 128 + 16 * s);
            acc[nb] = __builtin_amdgcn_mfma_f32_32x32x16_bf16(kf, qf, acc[nb], 0, 0, 0);
        }
    }
    int v[64];
#pragma unroll
    for (int nb = 0; nb < 4; ++nb)
#pragma unroll
        for (int i = 0; i < 16; ++i) {
            const int n = 32 * nb + (i & 3) + 8 * (i >> 2) + 4 * hh;
            v[nb * 16 + i] = (f2ord(acc[nb][i]) & ~127) | n;
        }
    int L[16];
    top16_of_64(v, L);
#pragma unroll
    for (int i = 0; i < 16; ++i) M[i] = imax(L[i], __shfl_xor(L[15 - i], 32));
    bitonic_merge16(M);
}

__device__ __forceinline__ void phase_route(const Args& a, int lane, int wave) {
    const bf16* qpb = (const bf16*)(a.ws + WS_QPB); const bf16* keysb = (const bf16*)(a.ws + WS_KEYSB);
    int* eidx = (int*)(a.ws + WS_EIDX); float* egate = (float*)(a.ws + WS_EGATE);
    const int r = lane & 31, hh = lane >> 5;
    for (int task = blockIdx.x * NWAVES + wave; task < (T / 32) * PH; task += gridDim.x * NWAVES) {
        const int tb = task >> 3, h = task & 7, t0 = tb * 32;
        int listA[16], listB[16];
        route_scores(qpb, keysb, t0, h, 0, r, hh, listA);
        __builtin_amdgcn_sched_barrier(0);
        route_scores(qpb, keysb, t0, h, 1, r, hh, listB);
        __builtin_amdgcn_sched_barrier(0);
        float fa[16], fb[16];
#pragma unroll
        for (int i = 0; i < 16; ++i) { fa[i] = ord2f(listA[i] & ~127); fb[i] = ord2f(listB[i] & ~127); }
        int cv[64];
        {
            int c = 0;
#pragma unroll
            for (int i = 0; i < 16; ++i)
#pragma unroll
                for (int j = 0; j < 16; ++j)
                    if ((i + 1) * (j + 1) <= 16) { cv[c] = (f2ord(fa[i] + fb[j]) & ~255) | (i * 16 + j); ++c; }
#pragma unroll
            for (int q = 50; q < 64; ++q) cv[q] = (int)0x80000000;
        }
        int sel[16];
        top16_of_64(cv, sel);
        int ia[4], ib[4];
#pragma unroll
        for (int q = 0; q < 4; ++q) {
            ia[q] = (listA[4 * q] & 127) | ((listA[4 * q + 1] & 127) << 8) | ((listA[4 * q + 2] & 127) << 16) | ((listA[4 * q + 3] & 127) << 24);
            ib[q] = (listB[4 * q] & 127) | ((listB[4 * q + 1] & 127) << 8) | ((listB[4 * q + 2] & 127) << 16) | ((listB[4 * q + 3] & 127) << 24);
        }
        float val[16]; int ex[16];
        float mx = -3.0e38f;
#pragma unroll
        for (int k = 0; k < 16; ++k) {
            const int pos = sel[k] & 255, i = pos >> 4, j = pos & 15;
            val[k] = ord2f(sel[k] & ~255);
            mx = fmaxf(mx, val[k]);
            const int na = (sel4(ia[0], ia[1], ia[2], ia[3], i >> 2) >> ((i & 3) * 8)) & 127;
            const int nb_ = (sel4(ib[0], ib[1], ib[2], ib[3], j >> 2) >> ((j & 3) * 8)) & 127;
            ex[k] = na * PN + nb_;
        }
        float sum = 0.f;
#pragma unroll
        for (int k = 0; k < 16; ++k) { val[k] = __expf(val[k] - mx); sum += val[k]; }
        const float inv = 1.f / sum;
        if (hh == 0) {
            const size_t ob = ((size_t)(t0 + r) * PH + h) * PK;
#pragma unroll
            for (int q = 0; q < 4; ++q) {
                *(v4u*)(eidx + ob + 4 * q) = (v4u){(unsigned)ex[4 * q], (unsigned)ex[4 * q + 1], (unsigned)ex[4 * q + 2], (unsigned)ex[4 * q + 3]};
                *(f32x4*)(egate + ob + 4 * q) = (f32x4){val[4 * q] * inv, val[4 * q + 1] * inv, val[4 * q + 2] * inv, val[4 * q + 3] * inv};
            }
        }
    }
}


typedef float f32x2v __attribute__((ext_vector_type(2)));
__device__ __forceinline__ float wave_max(float v) {
#pragma unroll
    for (int o = 1; o < 64; o <<= 1) v = fmaxf(v, __shfl_xor(v, o));
    return v;
}
__device__ __forceinline__ void p0_tables(const Args& a, LAS unsigned char* lds, int lane, int wave, int first_block, int nblocks, int grp_lo, int grp_hi) {
    LAS unsigned* stage = (LAS unsigned*)lds;
    int grp = grp_lo + (int)blockIdx.x - first_block;
    if (grp >= grp_hi) return;
    f32x4 v[16];
    {   const int row = grp * 8 + wave, up = row >= NE, e = up ? row - NE : row;
        const float* src = (up ? a.in[13] : a.in[12]) + (size_t)e * D;
#pragma unroll
        for (int j = 0; j < 16; ++j) v[j] = __builtin_nontemporal_load((const f32x4*)(src + 4 * (lane + 64 * j))); }
    for (; grp < grp_hi; grp += nblocks) {
        const int row = grp * 8 + wave, up = row >= NE, e = up ? row - NE : row;
        float* scl = (float*)(a.ws + (up ? WS_SU : WS_SD));
        float m = 0.f;
#pragma unroll
        for (int j = 0; j < 16; ++j) m = fmaxf(fmaxf(m, fmaxf(fabsf(v[j][0]), fabsf(v[j][1]))), fmaxf(fabsf(v[j][2]), fabsf(v[j][3])));
        m = wave_max(m);
        const float inv = m > 0.f ? 440.f / m : 0.f;
#pragma unroll
        for (int j = 0; j < 16; ++j) {
            int p = 0;
            p = __builtin_amdgcn_cvt_pk_fp8_f32(v[j][0] * inv, v[j][1] * inv, p, false);
            p = __builtin_amdgcn_cvt_pk_fp8_f32(v[j][2] * inv, v[j][3] * inv, p, true);
            stage[wave * 1024 + lane + 64 * j] = (unsigned)p;
        }
        if (lane == 0) scl[e] = m * (1.f / 440.f);
        if (grp + nblocks < grp_hi) {
            const int rown = (grp + nblocks) * 8 + wave, upn = rown >= NE, en = upn ? rown - NE : rown;
            const float* src = (upn ? a.in[13] : a.in[12]) + (size_t)en * D;
#pragma unroll
            for (int j = 0; j < 16; ++j) v[j] = __builtin_nontemporal_load((const f32x4*)(src + 4 * (lane + 64 * j)));
        }
        LDS_WAIT(); __builtin_amdgcn_s_barrier();
        {
            const int e0 = (grp * 8) % NE, r8 = lane >> 3, pc = lane & 7;
            unsigned char* dstb = a.ws + ((grp * 8 >= NE) ? WS_WU8 : WS_WD8);
#pragma unroll
            for (int q = 0; q < 4; ++q) {
                const int ds = wave * 4 + q;
                const v4u t = *(const LAS v4u*)(stage + r8 * 1024 + ds * 32 + pc * 4);
                __builtin_nontemporal_store(t, (v4u*)(dstb + (size_t)ds * (NE * 128) + (size_t)(e0 + r8) * 128 + pc * 16));
            }
        }
        LDS_WAIT(); __builtin_amdgcn_s_barrier();
    }
}

__device__ __forceinline__ float dot16_fp8(const v4u w, const f32x4 (&x)[4], float p) {
#pragma unroll
    for (int q = 0; q < 4; ++q) {
        const f32x2v lo = __builtin_amdgcn_cvt_pk_f32_fp8((int)w[q], false), hi = __builtin_amdgcn_cvt_pk_f32_fp8((int)w[q], true);
        p = fmaf(lo[0], x[q][0], p); p = fmaf(lo[1], x[q][1], p); p = fmaf(hi[0], x[q][2], p); p = fmaf(hi[1], x[q][3], p);
    }
    return p;
}


typedef int i32x4v __attribute__((ext_vector_type(4)));
typedef _Float16 h2v __attribute__((ext_vector_type(2)));
#define BF8_H(w, sel) __builtin_bit_cast(h2v, __builtin_amdgcn_perm((unsigned)(w), 0u, (sel)))
#define FP8_H(w, hi) __builtin_bit_cast(h2v, __builtin_amdgcn_cvt_scalef32_pk_f16_fp8((int)(w), 0.00390625f, (hi)))
__device__ __forceinline__ v4u tbl_load(__amdgpu_buffer_rsrc_t rs, unsigned voff, unsigned soff) {
    return __builtin_bit_cast(v4u, __builtin_amdgcn_raw_buffer_load_b128(rs, (int)voff, (int)soff, 0)); }

template <int PROBE>
__device__ __forceinline__ void phase_expert_down(const Args& a, int lane, int wave) {
    unsigned char* ws = a.ws;
    const float* sd = (const float*)(ws + WS_SD); const float* su = (const float*)(ws + WS_SU);
    const int* eidx = (const int*)(ws + WS_EIDX); const float* egate = (const float*)(ws + WS_EGATE);
    const bf16* x1b = (const bf16*)(ws + WS_X1B); float* abuf = (float*)(ws + (PROBE ? WS_XB : WS_ABUF));
    const __amdgpu_buffer_rsrc_t rs = __builtin_amdgcn_make_buffer_rsrc((void*)(ws + WS_WD8), 0, NE * D, 0x00020000);
    const int r8 = lane >> 3, pc = lane & 7;
    for (int tb = blockIdx.x * NWAVES + wave; tb < T / 4; tb += gridDim.x * NWAVES) {
        const int t0 = tb * 4;
        unsigned epk[4][8];
#pragma unroll
        for (int q = 0; q < 4; ++q)
#pragma unroll
            for (int k = 0; k < 8; ++k) epk[q][k] = (unsigned)eidx[(size_t)(t0 + q) * 128 + 8 * (2 * k) + r8] | ((unsigned)eidx[(size_t)(t0 + q) * 128 + 8 * (2 * k + 1) + r8] << 16);
        const unsigned pco = (unsigned)pc * 16u;
        float acc[4][16];
#pragma unroll
        for (int q = 0; q < 4; ++q)
#pragma unroll
            for (int k = 0; k < 16; ++k) acc[q][k] = 0.f;
        for (int ds = 0; ds < 32; ++ds) {
            const unsigned soff = (unsigned)ds * (unsigned)(NE * 128);
#pragma unroll
            for (int q = 0; q < 4; ++q) {
#pragma unroll
                for (int k = 0; k < 8; ++k) asm volatile("" : "+v"(epk[q][k]));
                const bf16* xp = x1b + (size_t)(t0 + q) * D + ds * 128 + pc * 16;
                const v4u xa = *(const v4u*)xp, xb = *(const v4u*)(xp + 8);
                v4u w[16];
#pragma unroll
                for (int k = 0; k < 16; ++k) { unsigned eo = ((((k & 1) ? (epk[q][k >> 1] >> 16) : (epk[q][k >> 1] & 0xffffu)) << 7) + pco);
                    if (PROBE == 1) eo &= 0xffffu;
                    w[k] = tbl_load(rs, eo, soff); }
                h2v xs[8];
#pragma unroll
                for (int i = 0; i < 4; ++i) { xs[i] = __builtin_convertvector((f32x2v){bflo(xa[i]), bfhi(xa[i])}, h2v); xs[4 + i] = __builtin_convertvector((f32x2v){bflo(xb[i]), bfhi(xb[i])}, h2v); }
#pragma unroll
                for (int k = 0; k < 16; ++k) {
                    if (PROBE == 2) { acc[q][k] += __builtin_bit_cast(float, (w[k][0] ^ w[k][1] ^ w[k][2] ^ w[k][3]) & 0x3fffffffu) * (float)xs[0][0]; continue; }
                    h2v t = (h2v){(_Float16)0.f, (_Float16)0.f};
#pragma unroll
                    for (int d = 0; d < 4; ++d) { t = __builtin_elementwise_fma(FP8_H(w[k][d], false), xs[2 * d], t); t = __builtin_elementwise_fma(FP8_H(w[k][d], true), xs[2 * d + 1], t); }
                    acc[q][k] += (float)t[0] + (float)t[1];
                }
            }
        }
#pragma unroll
        for (int q = 0; q < 4; ++q)
#pragma unroll
            for (int k0 = 0; k0 < 16; k0 += 8) {
                float r4[4], r2[2];
#pragma unroll
                for (int k = 0; k < 4; ++k) { const bool o = lane & 1; const float keep = o ? acc[q][k0 + 2 * k + 1] : acc[q][k0 + 2 * k], send = o ? acc[q][k0 + 2 * k] : acc[q][k0 + 2 * k + 1]; r4[k] = keep + __shfl_xor(send, 1); }
#pragma unroll
                for (int k = 0; k < 2; ++k) { const bool o = lane & 2; const float keep = o ? r4[2 * k + 1] : r4[2 * k], send = o ? r4[2 * k] : r4[2 * k + 1]; r2[k] = keep + __shfl_xor(send, 2); }
                const bool o = lane & 4; const float keep = o ? r2[1] : r2[0], send = o ? r2[0] : r2[1];
                const float z = keep + __shfl_xor(send, 4);
                const size_t pi = (size_t)(t0 + q) * 128 + 8 * (k0 + pc) + r8;
                const int e = eidx[pi];
                abuf[pi] = gelu_f(z * (256.f * sd[e])) * egate[pi] * (256.f * su[e]);
            }
    }
}

template <int PROBE>
__device__ __forceinline__ void phase_expert_up(const Args& a, LAS unsigned char* lds, int lane, int wave) {
    unsigned char* ws = a.ws;
    const int* eidx = (const int*)(ws + WS_EIDX);
    const bf16* x1b = (const bf16*)(ws + WS_X1B); const float* abuf = (const float*)(ws + WS_ABUF); float* out = a.out;
    bf16* vb16 = (bf16*)(ws + WS_PRE1);
    const float* g2 = a.in[14]; const float* b2 = a.in[15];
    const __amdgpu_buffer_rsrc_t rs = __builtin_amdgcn_make_buffer_rsrc((void*)(ws + WS_WU8), 0, NE * D, 0x00020000);
    const int r8 = lane >> 3, pc = lane & 7;
    LAS unsigned* lw = (LAS unsigned*)(lds + wave * 16384) + lane;
    for (int tb = blockIdx.x * NWAVES + wave; tb < T / 4; tb += gridDim.x * NWAVES) {
        const int t0 = tb * 4;
#pragma unroll
        for (int q = 0; q < 4; ++q) {
#pragma unroll
            for (int k = 0; k < 8; ++k) {
                lw[(q * 16 + k) * 64] = (unsigned)eidx[(size_t)(t0 + q) * 128 + 8 * (2 * k) + r8] | ((unsigned)eidx[(size_t)(t0 + q) * 128 + 8 * (2 * k + 1) + r8] << 16);
                lw[(q * 16 + 8 + k) * 64] = __builtin_bit_cast(unsigned, __builtin_convertvector((f32x2v){abuf[(size_t)(t0 + q) * 128 + 8 * (2 * k) + r8], abuf[(size_t)(t0 + q) * 128 + 8 * (2 * k + 1) + r8]}, h2v));
            }
        }
        LDS_WAIT();
        const unsigned pco = (unsigned)pc * 16u;
        float s1[4], s2[4];
#pragma unroll
        for (int q = 0; q < 4; ++q) { s1[q] = 0.f; s2[q] = 0.f; }
#define UP_OFF(ek, k) ((((((k) & 1) ? (ek[((k) & 7) >> 1] >> 16) : (ek[((k) & 7) >> 1] & 0xffffu)) << 7) + pco) & (PROBE ? 0xffffu : 0xffffffffu))
#define UP_EK(dst, q, kh) _Pragma("unroll") for (int j = 0; j < 4; ++j) dst[j] = lw[((q) * 16 + (kh) / 2 + j) * 64];
#define UP_LD(dst, ek, so) _Pragma("unroll") for (int k = 0; k < 8; ++k) dst[k] = tbl_load(rs, UP_OFF(ek, k), so);
#define UP_MM(src, q, kh) { unsigned ak[4]; _Pragma("unroll") for (int j = 0; j < 4; ++j) ak[j] = lw[((q) * 16 + 8 + (kh) / 2 + j) * 64]; \
        _Pragma("unroll") for (int k = 0; k < 8; ++k) { \
            const h2v ap = __builtin_bit_cast(h2v, ak[k >> 1]); const h2v s2v = (k & 1) ? (h2v){ap[1], ap[1]} : (h2v){ap[0], ap[0]}; \
            _Pragma("unroll") for (int d = 0; d < 4; ++d) { \
                y[2 * d] = __builtin_elementwise_fma(FP8_H(src[k][d], false), s2v, y[2 * d]); y[2 * d + 1] = __builtin_elementwise_fma(FP8_H(src[k][d], true), s2v, y[2 * d + 1]); } } }
#define SBR() __builtin_amdgcn_sched_barrier(0)
        v4u wa[8], wb[8];
        unsigned eka[4], ekb[4];
        { UP_EK(eka, 0, 0); UP_LD(wa, eka, 0u); UP_EK(ekb, 0, 8); }
        for (int ds = 0; ds < 32; ++ds) {
            const unsigned soff = (unsigned)ds * (unsigned)(NE * 128);
            const unsigned soffn = (unsigned)(ds + 1 < 32 ? ds + 1 : ds) * (unsigned)(NE * 128);
#pragma unroll
            for (int q = 0; q < 4; ++q) {
                h2v y[8];
#pragma unroll
                for (int i = 0; i < 8; ++i) y[i] = (h2v){(_Float16)0.f, (_Float16)0.f};
                const size_t oi = (size_t)(t0 + q) * D + ds * 128 + pc * 16 + 2 * r8;
                const unsigned xw = *(const unsigned*)(x1b + oi);
                UP_LD(wb, ekb, soff);
                if (q < 3) { UP_EK(eka, q + 1, 0); } else { UP_EK(eka, 0, 0); }
                SBR(); UP_MM(wa, q, 0); SBR();
                if (q < 3) { UP_LD(wa, eka, soff); UP_EK(ekb, q + 1, 8); } else { UP_LD(wa, eka, soffn); UP_EK(ekb, 0, 8); }
                SBR(); UP_MM(wb, q, 8); SBR();
                h2v y4[4], y2[2];
#pragma unroll
                for (int i = 0; i < 4; ++i) { const bool o = lane & 32; const h2v keep = o ? y[4 + i] : y[i], send = o ? y[i] : y[4 + i];
                    y4[i] = keep + __builtin_bit_cast(h2v, __shfl_xor(__builtin_bit_cast(int, send), 32)); }
#pragma unroll
                for (int i = 0; i < 2; ++i) { const bool o = lane & 16; const h2v keep = o ? y4[2 + i] : y4[i], send = o ? y4[i] : y4[2 + i];
                    y2[i] = keep + __builtin_bit_cast(h2v, __shfl_xor(__builtin_bit_cast(int, send), 16)); }
                f32x2v yv; { const bool o = lane & 8; const h2v keep = o ? y2[1] : y2[0], send = o ? y2[0] : y2[1];
                    const h2v yh = keep + __builtin_bit_cast(h2v, __shfl_xor(__builtin_bit_cast(int, send), 8)); yv = (f32x2v){(float)yh[0], (float)yh[1]}; }
                f32x2v v = (f32x2v){bflo(xw), bfhi(xw)} * ALPHA + yv;
                const unsigned vw = pkbf(v[0], v[1]);
                v = (f32x2v){bflo(vw), bfhi(vw)};
                s1[q] += v[0] + v[1]; s2[q] = fmaf(v[0], v[0], fmaf(v[1], v[1], s2[q]));
                *(unsigned*)(vb16 + oi) = vw;
            }
        }
#undef UP_OFF
#undef UP_EK
#undef UP_LD
#undef UP_MM
#undef SBR
#pragma unroll
        for (int q = 0; q < 4; ++q) {
            const float mean = wave_sum(s1[q]) * (1.f / D);
            const float var = wave_sum(s2[q]) * (1.f / D) - mean * mean;
            const float rstd = rsqrtf(fmaxf(var, 0.f) + LN_EPS);
            float* orow = out + (size_t)(t0 + q) * D; const bf16* vrow = vb16 + (size_t)(t0 + q) * D;
#pragma unroll
            for (int j = 0; j < 8; ++j) { const int c = 8 * (lane + 64 * j);
                const v4u vv = __builtin_nontemporal_load((const v4u*)(vrow + c));
                const f32x4 g0 = *(const f32x4*)(g2 + c), g1 = *(const f32x4*)(g2 + c + 4), b0 = *(const f32x4*)(b2 + c), b1 = *(const f32x4*)(b2 + c + 4);
                const f32x4 v0 = (f32x4){bflo(vv.x), bfhi(vv.x), bflo(vv.y), bfhi(vv.y)}, v1 = (f32x4){bflo(vv.z), bfhi(vv.z), bflo(vv.w), bfhi(vv.w)};
                __builtin_nontemporal_store((v0 - mean) * rstd * g0 + b0, (f32x4*)(orow + c)); __builtin_nontemporal_store((v1 - mean) * rstd * g1 + b1, (f32x4*)(orow + c + 4)); }
        }
    }
}


constexpr size_t GU_FR = 16 * 64 * 8 * 2;
constexpr size_t WS_G_KA = WS_PRE1;
constexpr size_t WS_G_QA = WS_G_KA + (size_t)2048 * GU_FR;
constexpr size_t WS_G_VB = WS_G_QA + (size_t)2048 * GU_FR;
constexpr size_t WS_G_KBT = WS_G_VB + (size_t)2048 * GU_FR;
constexpr size_t WS_G_KDT = WS_G_KBT + (size_t)2048 * GU_FR;
constexpr size_t WS_G_WN = WS_G_KDT + (size_t)2048 * GU_FR;
constexpr size_t WS_G_QKM = WS_G_WN + (size_t)2048 * GU_FR;
constexpr size_t WS_G_UU = WS_G_QKM + (size_t)2048 * 6 * 1024;
constexpr size_t WS_G_GC = WS_G_UU + (size_t)2048 * 32768;
constexpr size_t WS_G_BT = WS_G_GC + (size_t)2048 * 256;
constexpr size_t WS_G_END = WS_G_BT + (size_t)2048 * 256;
static_assert(WS_G_END <= WS_KEYSB, "GDN scratch must fit in the PRE1..QPB region (all written after the GDN is done)");

__device__ __forceinline__ bf16x8 ldfrag(const bf16* base, int frag, int lane) { return *(const bf16x8*)(base + ((size_t)frag * 64 + lane) * 8); }
__device__ __forceinline__ void stfrag(bf16* base, int frag, int lane, v4u v) { *(v4u*)(base + ((size_t)frag * 64 + lane) * 8) = v; }
__device__ __forceinline__ v4u pack8(float a0, float a1, float a2, float a3, float a4, float a5, float a6, float a7) {
    v4u o; o.x = pkbf(a0, a1); o.y = pkbf(a2, a3); o.z = pkbf(a4, a5); o.w = pkbf(a6, a7); return o; }
__device__ __forceinline__ bf16x8 packacc(const f32x16& x, int s) {
    return __builtin_bit_cast(bf16x8, pack8(x[8 * s], x[8 * s + 1], x[8 * s + 2], x[8 * s + 3], x[8 * s + 4], x[8 * s + 5], x[8 * s + 6], x[8 * s + 7])); }
#define MFMA32(a, b, c) __builtin_amdgcn_mfma_f32_32x32x16_bf16((a), (b), (c), 0, 0, 0)

constexpr int P2_LD = 129;
__device__ __forceinline__ void prep_load_rows(const bf16* projb, int tbase, int c, int h, int tid, v4u (&R)[11]) {
    const int ten = tid >> 7, rem = tid & 127, tg = rem >> 4, cc = rem & 15, col = ten * GW + h * GD + cc * 8;
#pragma unroll
    for (int i = 0; i < 11; ++i) {
        const int tok = tg * 8 - 3 + i;
        if (c * 64 + tok >= 0) R[i] = *(const v4u*)(projb + (size_t)(tbase + tok) * NP + col);
        else R[i] = (v4u){0u, 0u, 0u, 0u};
    }
}
__device__ __forceinline__ void phase_gdn_prep(const Args& a, LAS unsigned char* lds, int tid, int lane, int wave) {
    unsigned char* ws = a.ws;
    const bf16* projb = (const bf16*)(ws + WS_PROJ); const float* braw = (const float*)(ws + WS_BRAW);
    const float* conv_qkv = a.in[2]; const float* a_log = a.in[3]; const float* dt_bias = a.in[4];
    LAS float* xs = (LAS float*)lds;
    LAS float* ssq = xs + 3 * 64 * P2_LD;
    LAS float* gcs = ssq + 256;
    LAS float* bts = gcs + 64;
    LAS float* cw = bts + 64;
    for (int grp = blockIdx.x; grp < 256; grp += gridDim.x) {
        const int bh = grp >> 2, c0 = (grp & 3) * 8, b = bh >> 4, h = bh & 15;
        for (int e = tid; e < 4 * 384; e += NTHREADS) { const int j = e / 384, cl = e % 384; cw[e] = conv_qkv[j * 3 * GW + (cl >> 7) * GW + h * GD + (cl & 127)]; }
        if (tid < 256) ssq[tid] = 0.f;
        v4u R[11], Rn[11];
        float braw_b = 0.f, braw_a = 0.f;
        if (tid < 384) prep_load_rows(projb, b * S + c0 * 64, c0, h, tid, R);
        if (wave == 7) { const int t = b * S + c0 * 64 + lane; braw_b = braw[(size_t)t * 32 + h]; braw_a = braw[(size_t)t * 32 + 16 + h]; }
        __syncthreads();
        for (int ci = 0; ci < 8; ++ci) {
            const int c = c0 + ci, u = bh * 32 + c, sb = ci & 1;
            LAS float* sq = ssq + sb * 128;
            if (ci + 1 < 8 && tid < 384) prep_load_rows(projb, b * S + (c + 1) * 64, c + 1, h, tid, Rn);
            if (tid < 384) {
                const int ten = tid >> 7, rem = tid & 127, tg = rem >> 4, cc = rem & 15;
                float wv[4][8];
#pragma unroll
                for (int j = 0; j < 4; ++j)
#pragma unroll
                    for (int e = 0; e < 8; ++e) wv[j][e] = cw[j * 384 + ten * 128 + cc * 8 + e];
#pragma unroll
                for (int i = 0; i < 8; ++i) {
                    float acc[8];
#pragma unroll
                    for (int e = 0; e < 8; ++e) acc[e] = 0.f;
#pragma unroll
                    for (int j = 0; j < 4; ++j) { const v4u w = R[i + j];
                        acc[0] = fmaf(wv[j][0], bflo(w.x), acc[0]); acc[1] = fmaf(wv[j][1], bfhi(w.x), acc[1]); acc[2] = fmaf(wv[j][2], bflo(w.y), acc[2]); acc[3] = fmaf(wv[j][3], bfhi(w.y), acc[3]);
                        acc[4] = fmaf(wv[j][4], bflo(w.z), acc[4]); acc[5] = fmaf(wv[j][5], bfhi(w.z), acc[5]); acc[6] = fmaf(wv[j][6], bflo(w.w), acc[6]); acc[7] = fmaf(wv[j][7], bfhi(w.w), acc[7]); }
                    float s2 = 0.f; const int tok = tg * 8 + i;
#pragma unroll
                    for (int e = 0; e < 8; ++e) { acc[e] = silu_f(acc[e]); s2 = fmaf(acc[e], acc[e], s2); xs[(ten * 64 + tok) * P2_LD + cc * 8 + e] = acc[e]; }
                    if (ten < 2) atomicAdd((float*)(sq + ten * 64 + tok), s2);
                }
            }
            if (wave == 7) {
                const float be = sigmoid_f(braw_b);
                float g = -expf(a_log[h]) * softplus_f(braw_a + dt_bias[h]);
#pragma unroll
                for (int o = 1; o < 64; o <<= 1) { const float n = __shfl_up(g, o); if (lane >= o) g += n; }
                gcs[lane] = g; bts[lane] = be;
                ((float*)(ws + WS_G_GC))[(size_t)u * 64 + lane] = g; ((float*)(ws + WS_G_BT))[(size_t)u * 64 + lane] = be;
            }
            LDS_WAIT(); __builtin_amdgcn_s_barrier();
            if (ci + 1 < 8) {
                if (tid < 384) {
#pragma unroll
                    for (int i = 0; i < 11; ++i) R[i] = Rn[i];
                }
                if (wave == 7) { const int t = b * S + (c + 1) * 64 + lane; braw_b = braw[(size_t)t * 32 + h]; braw_a = braw[(size_t)t * 32 + 16 + h]; }
            }
            if (tid < 128) ssq[(sb ^ 1) * 128 + tid] = 0.f;
            const float glast = gcs[63];
#pragma unroll
            for (int i = 0; i < 10; ++i) {
                const int f = tid + 512 * i, buf = f >> 10, fr = (f >> 6) & 15, l = f & 63, r = l & 31, hh = l >> 5;
                float o[8];
                if (buf < 2) {
                    const int I = fr >> 3, s = fr & 7, ten = buf == 0 ? 1 : 0, row = 32 * I + r;
                    const float sc = rsqrtf(sq[ten * 64 + row] + RMS_EPS) * (buf == 0 ? 1.f : 0.08838834764831845f);
#pragma unroll
                    for (int j = 0; j < 8; ++j) o[j] = xs[(ten * 64 + row) * P2_LD + 16 * s + 8 * (j >> 2) + 4 * hh + (j & 3)] * sc;
                } else if (buf == 2) {
                    const int s = fr >> 2, cb = fr & 3;
#pragma unroll
                    for (int j = 0; j < 8; ++j) { const int tok = 16 * s + 8 * hh + j; o[j] = xs[(2 * 64 + tok) * P2_LD + 32 * cb + r] * bts[tok]; }
                } else if (buf == 3) {
                    const int cb = fr >> 2, s = fr & 3;
#pragma unroll
                    for (int j = 0; j < 8; ++j) { const int tok = 16 * s + 8 * hh + j;
                        o[j] = xs[(1 * 64 + tok) * P2_LD + 32 * cb + r] * (rsqrtf(sq[64 + tok] + RMS_EPS) * bts[tok] * __expf(gcs[tok])); }
                } else {
                    const int cp = fr >> 2, J = (fr >> 1) & 1, sp = fr & 1;
#pragma unroll
                    for (int j = 0; j < 8; ++j) { const int tok = 32 * J + 16 * sp + 8 * (j >> 2) + 4 * hh + (j & 3);
                        o[j] = xs[(1 * 64 + tok) * P2_LD + 32 * cp + r] * (rsqrtf(sq[64 + tok] + RMS_EPS) * __expf(glast - gcs[tok])); }
                }
                bf16* dst = (bf16*)(ws + (buf == 0 ? WS_G_KA : buf == 1 ? WS_G_QA : buf == 2 ? WS_G_VB : buf == 3 ? WS_G_KBT : WS_G_KDT)) + (size_t)u * (GU_FR / 2);
                stfrag(dst, fr, l, pack8(o[0], o[1], o[2], o[3], o[4], o[5], o[6], o[7]));
            }
            LDS_WAIT(); __builtin_amdgcn_s_barrier();
        }
    }
    {
        const float* conv_short = a.in[6]; unsigned char* cat8 = ws + WS_CAT;
        for (int item = blockIdx.x * NTHREADS + tid; item < (T / 16) * (GW / 8); item += gridDim.x * NTHREADS) {
            const int run = item >> 8, cc = item & 255, col = cc * 8, tfirst = run * 16;
            float cw3[3][8];
#pragma unroll
            for (int jt = 0; jt < 3; ++jt) { const f32x4 c0 = *(const f32x4*)(conv_short + jt * GW + col), c1 = *(const f32x4*)(conv_short + jt * GW + col + 4);
#pragma unroll
                for (int e = 0; e < 4; ++e) { cw3[jt][e] = c0[e]; cw3[jt][4 + e] = c1[e]; } }
            float p1[8], p2[8];
#pragma unroll
            for (int e = 0; e < 8; ++e) { p1[e] = 0.f; p2[e] = 0.f; }
            if ((tfirst & (S - 1)) != 0) {
                const size_t r1 = (size_t)(tfirst - 1) * NP, r2 = (size_t)(tfirst - 2) * NP;
                const v4u g1 = *(const v4u*)(projb + r1 + PGC0 + col), h1 = *(const v4u*)(projb + r1 + PH0 + col), g2 = *(const v4u*)(projb + r2 + PGC0 + col), h2 = *(const v4u*)(projb + r2 + PH0 + col);
#pragma unroll
                for (int e = 0; e < 4; ++e) { p1[2 * e] = bflo(g1[e]) * bflo(h1[e]); p1[2 * e + 1] = bfhi(g1[e]) * bfhi(h1[e]); p2[2 * e] = bflo(g2[e]) * bflo(h2[e]); p2[2 * e + 1] = bfhi(g2[e]) * bfhi(h2[e]); }
            }
#pragma unroll 4
            for (int i = 0; i < 16; ++i) {
                const size_t row = (size_t)(tfirst + i) * NP;
                const v4u gc = *(const v4u*)(projb + row + PGC0 + col), hv = *(const v4u*)(projb + row + PH0 + col), gb = *(const v4u*)(projb + row + PGB0 + col);
                float p0[8], y[8];
#pragma unroll
                for (int e = 0; e < 4; ++e) { p0[2 * e] = bflo(gc[e]) * bflo(hv[e]); p0[2 * e + 1] = bfhi(gc[e]) * bfhi(hv[e]); }
#pragma unroll
                for (int e = 0; e < 8; ++e) y[e] = fmaf(cw3[2][e], p0[e], fmaf(cw3[1][e], p1[e], cw3[0][e] * p2[e]));
                const unsigned long long o8 = (unsigned long long)pk4_fp8(y[0] * bflo(gb.x), y[1] * bfhi(gb.x), y[2] * bflo(gb.y), y[3] * bfhi(gb.y)) |
                                              ((unsigned long long)pk4_fp8(y[4] * bflo(gb.z), y[5] * bfhi(gb.z), y[6] * bflo(gb.w), y[7] * bfhi(gb.w)) << 32);
                *(unsigned long long*)(cat8 + (size_t)(tfirst + i) * D + GW + col) = o8;
#pragma unroll
                for (int e = 0; e < 8; ++e) { p2[e] = p1[e]; p1[e] = p0[e]; }
            }
        }
    }
    rescale_rows_fp8(ws + WS_WOUT8, (const signed char*)(ws + WS_ETAB_OUT), (float*)(ws + WS_SWOUT), (const unsigned*)(ws + WS_CTL + CTL_WOMAX), D, 1.f, lane, wave);
}

template <int J, int Q>
struct SubstInner {
    static __device__ __forceinline__ void run(const float (&Tr)[64], const LAS float* Mt, float& a0, float& a1) {
        if constexpr (Q < 16) {
            const f32x4 mq = *(const LAS f32x4*)(Mt + J * 64 + 4 * Q);
            if constexpr (4 * Q + 0 > J) a0 = fmaf(Tr[4 * Q + 0], mq[0], a0);
            if constexpr (4 * Q + 1 > J) a1 = fmaf(Tr[4 * Q + 1], mq[1], a1);
            if constexpr (4 * Q + 2 > J) a0 = fmaf(Tr[4 * Q + 2], mq[2], a0);
            if constexpr (4 * Q + 3 > J) a1 = fmaf(Tr[4 * Q + 3], mq[3], a1);
            SubstInner<J, Q + 1>::run(Tr, Mt, a0, a1);
        }
    }
};
template <int J>
struct SubstOuter {
    static __device__ __forceinline__ void run(float (&Tr)[64], const LAS float* Mt, int lane) {
        float a0 = 0.f, a1 = 0.f;
        SubstInner<J, (J + 1) / 4>::run(Tr, Mt, a0, a1);
        asm volatile("" : "+v"(lane));
        Tr[J] = (lane == J ? 1.f : 0.f) - (a0 + a1);
        asm volatile("" : "+v"(Mt), "+v"(Tr[J]));
        if constexpr (J > 0) SubstOuter<J - 1>::run(Tr, Mt, lane);
    }
};

__device__ __forceinline__ void phase_gdn_solve(const Args& a, LAS unsigned char* lds, int lane, int wave) {
    unsigned char* ws = a.ws;
    const int r = lane & 31, hh = lane >> 5;
    LAS float* Mt = (LAS float*)(lds + wave * 16384);
    for (int u = blockIdx.x * NWAVES + wave; u < 2048; u += gridDim.x * NWAVES) {
        const bf16* KA = (const bf16*)(ws + WS_G_KA) + (size_t)u * (GU_FR / 2); const bf16* QA = (const bf16*)(ws + WS_G_QA) + (size_t)u * (GU_FR / 2);
        const bf16* VB = (const bf16*)(ws + WS_G_VB) + (size_t)u * (GU_FR / 2); const bf16* KBT = (const bf16*)(ws + WS_G_KBT) + (size_t)u * (GU_FR / 2);
        bf16* WN = (bf16*)(ws + WS_G_WN) + (size_t)u * (GU_FR / 2); bf16* QKM = (bf16*)(ws + WS_G_QKM) + (size_t)u * (6 * 512);
        v4u* UU = (v4u*)(ws + WS_G_UU) + (size_t)u * 1024;
        const float* GC = (const float*)(ws + WS_G_GC) + (size_t)u * 64; const float* BT = (const float*)(ws + WS_G_BT) + (size_t)u * 64;
        const float gi0 = GC[r], gi1 = GC[32 + r], bi0 = BT[r], bi1 = BT[32 + r];
        f32x4 gm[2][4];
#pragma unroll
        for (int J = 0; J < 2; ++J)
#pragma unroll
            for (int g = 0; g < 4; ++g) gm[J][g] = *(const f32x4*)(GC + 32 * J + 8 * g + 4 * hh);
        {
            f32x16 q00, q10, q11;
#pragma unroll
            for (int i = 0; i < 16; ++i) { q00[i] = 0.f; q10[i] = 0.f; q11[i] = 0.f; }
#pragma unroll 2
            for (int s = 0; s < 8; ++s) {
                const bf16x8 k0 = ldfrag(KA, s, lane), k1 = ldfrag(KA, 8 + s, lane), qq0 = ldfrag(QA, s, lane), qq1 = ldfrag(QA, 8 + s, lane);
                q00 = MFMA32(k0, qq0, q00); q10 = MFMA32(k0, qq1, q10); q11 = MFMA32(k1, qq1, q11);
            }
#pragma unroll
            for (int i = 0; i < 16; ++i) {
                const int g = i >> 2, e = i & 3, mloc = e + 8 * g + 4 * hh;
                const float gj0 = gm[0][g][e], gj1 = gm[1][g][e];
                q00[i] = (mloc <= r) ? q00[i] * __expf(gi0 - gj0) : 0.f;
                q10[i] = q10[i] * __expf(gi1 - gj0);
                q11[i] = (mloc <= r) ? q11[i] * __expf(gi1 - gj1) : 0.f;
            }
            stfrag(QKM, 0, lane, __builtin_bit_cast(v4u, packacc(q00, 0))); stfrag(QKM, 1, lane, __builtin_bit_cast(v4u, packacc(q00, 1)));
            stfrag(QKM, 2, lane, __builtin_bit_cast(v4u, packacc(q10, 0))); stfrag(QKM, 3, lane, __builtin_bit_cast(v4u, packacc(q10, 1)));
            stfrag(QKM, 4, lane, __builtin_bit_cast(v4u, packacc(q11, 0))); stfrag(QKM, 5, lane, __builtin_bit_cast(v4u, packacc(q11, 1)));
        }
        __builtin_amdgcn_sched_barrier(0);
        f32x16 m00, m10, m11;
#pragma unroll
        for (int i = 0; i < 16; ++i) { m00[i] = 0.f; m10[i] = 0.f; m11[i] = 0.f; }
#pragma unroll 4
        for (int s = 0; s < 8; ++s) {
            const bf16x8 k0 = ldfrag(KA, s, lane), k1 = ldfrag(KA, 8 + s, lane);
            m00 = MFMA32(k0, k0, m00); m10 = MFMA32(k0, k1, m10); m11 = MFMA32(k1, k1, m11);
        }
#pragma unroll
        for (int i = 0; i < 16; ++i) {
            const int g = i >> 2, e = i & 3, mloc = e + 8 * g + 4 * hh;
            const float gj0 = gm[0][g][e], gj1 = gm[1][g][e];
            m00[i] = (mloc < r) ? bi0 * m00[i] * __expf(gi0 - gj0) : 0.f;
            m10[i] = bi1 * m10[i] * __expf(gi1 - gj0);
            m11[i] = (mloc < r) ? bi1 * m11[i] * __expf(gi1 - gj1) : 0.f;
        }
        int lane_o = lane; asm volatile("" : "+v"(lane_o));
        float Tr[64];
#pragma unroll
        for (int m = 0; m < 64; ++m) Tr[m] = 0.f;
        Tr[63] = (lane_o == 63) ? 1.f : 0.f;
        {
            LAS float* mb = Mt + 256 * hh + r;
#pragma unroll
            for (int i = 0; i < 16; ++i) {
                const int cc = (i & 3) + 8 * (i >> 2);
                mb[cc * 64] = m00[i]; mb[cc * 64 + 32] = m10[i]; mb[(32 + cc) * 64 + 32] = m11[i];
            }
        }
        LDS_WAIT(); asm volatile("" ::: "memory");
#ifndef DG_NOSUBST
        { const LAS float* Mt_o = Mt; asm volatile("" : "+v"(Mt_o));
          SubstOuter<62>::run(Tr, Mt_o, lane_o); }
#endif
        LDS_WAIT(); asm volatile("" ::: "memory");
        bf16x8 Tf[2][4];
#pragma unroll
        for (int s = 0; s < 4; ++s) {
            v4u X = pack8(Tr[16 * s], Tr[16 * s + 1], Tr[16 * s + 2], Tr[16 * s + 3], Tr[16 * s + 4], Tr[16 * s + 5], Tr[16 * s + 6], Tr[16 * s + 7]);
            v4u Y = pack8(Tr[16 * s + 8], Tr[16 * s + 9], Tr[16 * s + 10], Tr[16 * s + 11], Tr[16 * s + 12], Tr[16 * s + 13], Tr[16 * s + 14], Tr[16 * s + 15]);
#pragma unroll
            for (int d = 0; d < 4; ++d) { const auto sw = __builtin_amdgcn_permlane32_swap(X[d], Y[d], false, false); X[d] = sw[0]; Y[d] = sw[1]; }
            Tf[0][s] = __builtin_bit_cast(bf16x8, X); Tf[1][s] = __builtin_bit_cast(bf16x8, Y);
        }
#pragma unroll
        for (int c = 0; c < 4; ++c) {
            f32x16 u0, u1;
#pragma unroll
            for (int i = 0; i < 16; ++i) { u0[i] = 0.f; u1[i] = 0.f; }
#pragma unroll
            for (int s = 0; s < 4; ++s) { const bf16x8 vb = ldfrag(VB, s * 4 + c, lane); if (s < 2) u0 = MFMA32(Tf[0][s], vb, u0); u1 = MFMA32(Tf[1][s], vb, u1); }
#pragma unroll
            for (int q = 0; q < 2; ++q) {
                UU[((0 * 4 + c) * 2 + q) * 64 + lane] = (v4u){pk2(u0[8 * q], u0[8 * q + 1]), pk2(u0[8 * q + 2], u0[8 * q + 3]), pk2(u0[8 * q + 4], u0[8 * q + 5]), pk2(u0[8 * q + 6], u0[8 * q + 7])};
                UU[((1 * 4 + c) * 2 + q) * 64 + lane] = (v4u){pk2(u1[8 * q], u1[8 * q + 1]), pk2(u1[8 * q + 2], u1[8 * q + 3]), pk2(u1[8 * q + 4], u1[8 * q + 5]), pk2(u1[8 * q + 6], u1[8 * q + 7])}; }
        }
#pragma unroll
        for (int c = 0; c < 4; ++c) {
            f32x16 w0, w1;
#pragma unroll
            for (int i = 0; i < 16; ++i) { w0[i] = 0.f; w1[i] = 0.f; }
#pragma unroll
            for (int s = 0; s < 4; ++s) { const bf16x8 kb = ldfrag(KBT, c * 4 + s, lane); if (s < 2) w0 = MFMA32(kb, Tf[0][s], w0); w1 = MFMA32(kb, Tf[1][s], w1); }
#pragma unroll
            for (int i = 0; i < 16; ++i) { w0[i] = -w0[i]; w1[i] = -w1[i]; }
            stfrag(WN, (0 * 4 + c) * 2 + 0, lane, __builtin_bit_cast(v4u, packacc(w0, 0))); stfrag(WN, (0 * 4 + c) * 2 + 1, lane, __builtin_bit_cast(v4u, packacc(w0, 1)));
            stfrag(WN, (1 * 4 + c) * 2 + 0, lane, __builtin_bit_cast(v4u, packacc(w1, 0))); stfrag(WN, (1 * 4 + c) * 2 + 1, lane, __builtin_bit_cast(v4u, packacc(w1, 1)));
        }
    }
}

constexpr int SC_BUF = 56320;
constexpr int SC_SSL = 2 * SC_BUF;
__device__ __forceinline__ bf16x8 ldsfrag(const LAS unsigned char* buf, int frag, int lane) { return *(const LAS bf16x8*)(buf + frag * 1024 + lane * 16); }
__device__ __forceinline__ void scan_stage(unsigned char* ws, LAS unsigned char* dst, int u, int lw, int lane) {
    const unsigned char* wn = ws + WS_G_WN + (size_t)u * GU_FR; const unsigned char* qa = ws + WS_G_QA + (size_t)u * GU_FR;
    const unsigned char* kd = ws + WS_G_KDT + (size_t)u * GU_FR; const unsigned char* qk = ws + WS_G_QKM + (size_t)u * 6144;
    v4u v[14];
#pragma unroll
    for (int i = 0; i < 14; ++i) {
        const int f = lw + 4 * i;
        if (f < 54) { const unsigned char* src = f < 16 ? wn + f * 1024 : f < 32 ? qa + (f - 16) * 1024 : f < 48 ? kd + (f - 32) * 1024 : qk + (f - 48) * 1024;
            v[i] = *(const v4u*)(src + lane * 16); }
    }
    float gcv = 0.f;
    if (lw == 0) gcv = ((const float*)(ws + WS_G_GC))[(size_t)u * 64 + lane];
#pragma unroll
    for (int i = 0; i < 14; ++i) { const int f = lw + 4 * i; if (f < 54) *(LAS v4u*)(dst + f * 1024 + lane * 16) = v[i]; }
    if (lw == 0) ((LAS float*)(dst + 54 * 1024))[lane] = gcv;
    LDS_WAIT();
}
__device__ __forceinline__ void phase_gdn_scan(const Args& a, LAS unsigned char* lds, int lane, int wave) {
    unsigned char* ws = a.ws;
    const bf16* projb = (const bf16*)(ws + WS_PROJ); unsigned char* cat8 = ws + WS_CAT; const float* norm_w = a.in[5];
    LAS float* ssl = (LAS float*)(lds + SC_SSL);
    const int r = lane & 31, hh = lane >> 5, cs = wave & 3;
    const bool active = wave < 4;
    for (int bh = blockIdx.x; bh < NB * GH; bh += gridDim.x) {
        const int b = bh >> 4, h = bh & 15;
        f32x16 St[4];
#pragma unroll
        for (int cp = 0; cp < 4; ++cp)
#pragma unroll
            for (int i = 0; i < 16; ++i) St[cp][i] = 0.f;
        f32x4 nw[4];
#pragma unroll
        for (int g = 0; g < 4; ++g) nw[g] = *(const f32x4*)(norm_w + 32 * cs + 8 * g + 4 * hh);
        v4u un[2][2];
        if (active) {
            const v4u* UU = (const v4u*)(ws + WS_G_UU) + (size_t)(bh * 32) * 1024;
#pragma unroll
            for (int I = 0; I < 2; ++I)
#pragma unroll
                for (int q = 0; q < 2; ++q) un[I][q] = UU[((I * 4 + cs) * 2 + q) * 64 + lane];
        } else {
            scan_stage(ws, lds, bh * 32, wave - 4, lane);
        }
        __syncthreads();
        for (int c = 0; c < 32; ++c) {
            const int u = bh * 32 + c, buf = c & 1;
            f32x16 oT[2];
            unsigned long long zz[2][4];
            if (active) {
                const LAS unsigned char* B = lds + buf * SC_BUF;
                const LAS float* GC = (const LAS float*)(B + 54 * 1024);
                f32x16 vn[2];
#pragma unroll
                for (int I = 0; I < 2; ++I)
#pragma unroll
                    for (int q = 0; q < 2; ++q)
#pragma unroll
                        for (int j = 0; j < 4; ++j) { vn[I][8 * q + 2 * j] = bflo(un[I][q][j]); vn[I][8 * q + 2 * j + 1] = bfhi(un[I][q][j]); }
                if (c + 1 < 32) {
                    const v4u* UU = (const v4u*)(ws + WS_G_UU) + (size_t)(u + 1) * 1024;
#pragma unroll
                    for (int I = 0; I < 2; ++I)
#pragma unroll
                        for (int q = 0; q < 2; ++q) un[I][q] = UU[((I * 4 + cs) * 2 + q) * 64 + lane];
                }
#pragma unroll
                for (int I = 0; I < 2; ++I)
#pragma unroll
                    for (int g = 0; g < 4; ++g)
                        zz[I][g] = *(const unsigned long long*)(projb + (size_t)(b * S + c * 64 + 32 * I + r) * NP + Z0 + h * GD + 32 * cs + 8 * g + 4 * hh);
                bf16x8 Sf[4][2];
#pragma unroll
                for (int cp = 0; cp < 4; ++cp) { Sf[cp][0] = packacc(St[cp], 0); Sf[cp][1] = packacc(St[cp], 1); }
#pragma unroll
                for (int I = 0; I < 2; ++I) {
#pragma unroll
                    for (int i = 0; i < 16; ++i) oT[I][i] = 0.f;
#pragma unroll
                    for (int cp = 0; cp < 4; ++cp)
#pragma unroll
                        for (int sp = 0; sp < 2; ++sp) {
                            vn[I] = MFMA32(ldsfrag(B, (I * 4 + cp) * 2 + sp, lane), Sf[cp][sp], vn[I]);
                            oT[I] = MFMA32(Sf[cp][sp], ldsfrag(B, 16 + I * 8 + 2 * cp + sp, lane), oT[I]);
                        }
                    const float eg = __expf(GC[32 * I + r]);
#pragma unroll
                    for (int i = 0; i < 16; ++i) oT[I][i] *= eg;
                }
                bf16x8 Vf[2][2];
#pragma unroll
                for (int J = 0; J < 2; ++J) { Vf[J][0] = packacc(vn[J], 0); Vf[J][1] = packacc(vn[J], 1); }
#pragma unroll
                for (int sp = 0; sp < 2; ++sp) {
                    oT[0] = MFMA32(Vf[0][sp], ldsfrag(B, 48 + 0 + sp, lane), oT[0]);
                    oT[1] = MFMA32(Vf[0][sp], ldsfrag(B, 48 + 2 + sp, lane), oT[1]);
                    oT[1] = MFMA32(Vf[1][sp], ldsfrag(B, 48 + 4 + sp, lane), oT[1]);
                }
                const float dec = __expf(GC[63]);
#pragma unroll
                for (int cp = 0; cp < 4; ++cp) {
#pragma unroll
                    for (int i = 0; i < 16; ++i) St[cp][i] *= dec;
#pragma unroll
                    for (int J = 0; J < 2; ++J)
#pragma unroll
                        for (int sp = 0; sp < 2; ++sp) St[cp] = MFMA32(ldsfrag(B, 32 + cp * 4 + J * 2 + sp, lane), Vf[J][sp], St[cp]);
                }
#pragma unroll
                for (int I = 0; I < 2; ++I) {
                    float ss = 0.f;
#pragma unroll
                    for (int i = 0; i < 16; ++i) ss = fmaf(oT[I][i], oT[I][i], ss);
                    ss += __shfl_xor(ss, 32);
                    if (hh == 0) ssl[(buf * 4 + cs) * 64 + 32 * I + r] = ss;
                }
            } else if (c + 1 < 32) {
                scan_stage(ws, lds + (buf ^ 1) * SC_BUF, u + 1, wave - 4, lane);
            }
            __syncthreads();
            if (active) {
#pragma unroll
                for (int I = 0; I < 2; ++I) {
                    const int tok = 32 * I + r, t = b * S + c * 64 + tok;
                    const float tot = ssl[(buf * 4 + 0) * 64 + tok] + ssl[(buf * 4 + 1) * 64 + tok] + ssl[(buf * 4 + 2) * 64 + tok] + ssl[(buf * 4 + 3) * 64 + tok];
                    const float rstd = rsqrtf(tot * (1.f / GD) + RMS_EPS);
#pragma unroll
                    for (int g = 0; g < 4; ++g) {
                        const int dv = 32 * cs + 8 * g + 4 * hh;
                        const unsigned z01 = (unsigned)zz[I][g], z23 = (unsigned)(zz[I][g] >> 32);
                        const float o0 = oT[I][4 * g] * rstd * nw[g][0] * silu_f(bflo(z01)), o1 = oT[I][4 * g + 1] * rstd * nw[g][1] * silu_f(bfhi(z01));
                        const float o2 = oT[I][4 * g + 2] * rstd * nw[g][2] * silu_f(bflo(z23)), o3 = oT[I][4 * g + 3] * rstd * nw[g][3] * silu_f(bfhi(z23));
                        *(unsigned*)(cat8 + (size_t)t * D + h * GD + dv) = pk4_fp8(o0, o1, o2, o3);
                    }
                }
            }
        }
        __syncthreads();
    }
}


#define XB_TMO      128
#define XB_XCNT(j)  (256  + 64 * (j))
#define XB_XSUB(j)  (1280 + 64 * (j))
#define XB_XGEN(j)  (2304 + 64 * (j))
#define XB_TOP      3328
#define XB_TOPGEN   3392
#define XCD_BAR_WORDS 3456
#define XB_SPIN_CAP (1u << 18)

__device__ __forceinline__ unsigned xb_ld(unsigned* p)              { return __hip_atomic_load(p, __ATOMIC_RELAXED, __HIP_MEMORY_SCOPE_AGENT); }
__device__ __forceinline__ unsigned xb_add(unsigned* p, unsigned v) { return __hip_atomic_fetch_add(p, v, __ATOMIC_RELAXED, __HIP_MEMORY_SCOPE_AGENT); }
__device__ __forceinline__ unsigned xb_xcc_id() { return (unsigned)__builtin_amdgcn_s_getreg((3 << 11) | 20) & 0xFu; }
#define XB_SPIN(cond, bar) do { unsigned _sp = 0; while (cond) { __builtin_amdgcn_s_sleep(1); \
    if ((++_sp & 255u) == 0u) { if (xb_ld(&(bar)[XB_TMO])) break; if (_sp > XB_SPIN_CAP) { atomicAdd(&(bar)[XB_TMO], 1u); break; } } } } while (0)

struct XcdBarrier {
    unsigned* bar; unsigned x;
    volatile LAS unsigned* st;
};

__device__ __forceinline__ XcdBarrier xcd_barrier_post(unsigned* bar, volatile LAS unsigned* st) {
    XcdBarrier b; b.bar = bar; b.x = xb_xcc_id(); b.st = st;
    if (threadIdx.x == 0) (void)xb_add(&bar[XB_XCNT(b.x)], 1u);
    return b;
}
__device__ __forceinline__ void xcd_barrier_complete(unsigned* bar, unsigned x, unsigned& nloc, unsigned& nx) {
    const unsigned G = gridDim.x * gridDim.y * gridDim.z;
    unsigned sum, cnt, mine, sp = 0u;
    for (;;) {
        sum = 0u; cnt = 0u; mine = 0u;
#pragma unroll
        for (unsigned j = 0; j < 16; ++j) { const unsigned c = xb_ld(&bar[XB_XCNT(j)]); sum += c; cnt += (c > 0u) ? 1u : 0u; mine = (j == x) ? c : mine; }
        if (sum == G) break;
        __builtin_amdgcn_s_sleep(1);
        if ((++sp & 255u) == 0u) { if (xb_ld(&bar[XB_TMO])) break; if (sp > XB_SPIN_CAP) { atomicAdd(&bar[XB_TMO], 1u); break; } }
    }
    nloc = mine > 0u ? mine : 1u; nx = cnt > 0u ? cnt : 1u;
}

__device__ __forceinline__ void xcd_barrier(const XcdBarrier& b, int tid_in = -1) {
    const int tid_ = tid_in < 0 ? (int)threadIdx.x : tid_in;
    asm volatile("s_waitcnt vmcnt(0)" ::: "memory");
    __syncthreads();
    if (tid_ == 0) {
        unsigned* bar = b.bar;
        __builtin_amdgcn_s_waitcnt(0);
        unsigned nloc = b.st[0], nx = b.st[1];
        if (nloc == 0u) { xcd_barrier_complete(bar, b.x, nloc, nx); b.st[0] = nloc; b.st[1] = nx; }
        const unsigned old = xb_add(&bar[XB_XSUB(b.x)], 1u);
        const unsigned gen = old / nloc;
        if (old + 1u == (gen + 1u) * nloc) {
            __builtin_amdgcn_fence(__ATOMIC_RELEASE, "agent");
            asm volatile("s_waitcnt vmcnt(0)" ::: "memory");
            const unsigned og = xb_add(&bar[XB_TOP], 1u);
            const unsigned tg = og / nx;
            if (og + 1u == (tg + 1u) * nx) xb_add(&bar[XB_TOPGEN], 1u);
            else XB_SPIN(xb_ld(&bar[XB_TOPGEN]) == tg, bar);
            __builtin_amdgcn_fence(__ATOMIC_ACQUIRE, "agent");
            xb_add(&bar[XB_XGEN(b.x)], 1u);
            asm volatile("s_waitcnt vmcnt(0)" ::: "memory");
        } else {
            XB_SPIN(xb_ld(&bar[XB_XGEN(b.x)]) == gen, bar);
            __builtin_amdgcn_fence(__ATOMIC_ACQUIRE, "agent");
            asm volatile("s_waitcnt vmcnt(0)" ::: "memory");
        }
    }
    __syncthreads();
}

__global__ void __launch_bounds__(NTHREADS, 2) mk(Args a) {
    extern __shared__ __attribute__((aligned(16))) unsigned char lds_raw[];
    LAS unsigned char* lds = (LAS unsigned char*)lds_raw;
    cg::grid_group grid = cg::this_grid();
    const int tid = threadIdx.x, lane = tid & 63, wave = __builtin_amdgcn_readfirstlane(tid >> 6);
    volatile LAS unsigned* misc = (volatile LAS unsigned*)(lds + LDS_BYTES - 256);
    if (tid < 64) misc[tid] = 0u;
    __syncthreads();
    const XcdBarrier xbar = xcd_barrier_post((unsigned*)(a.ws + WS_CTL), misc);
    const int lo = a.ph_lo, hi = a.ph_hi;
    unsigned char* ws = a.ws;
#define IN(k) (lo <= (k) && (k) < hi)
#define SEAM(k) do { if (IN(k) && IN((k) + 1)) { if ((k) == 0 && lo < 0) grid.sync(); else xcd_barrier(xbar); } } while (0)
#define SEAM1(k) do { if (IN(k) && IN((k) + 1)) xcd_barrier(xbar, tid1); } while (0)
#define SEAM2(k) do { if (IN(k) && IN((k) + 1)) xcd_barrier(xbar, tid2); } while (0)
#define LOCAL_SEAM(k) do { if (IN(k) && IN((k) + 1)) { asm volatile("s_waitcnt vmcnt(0)" ::: "memory"); __syncthreads(); } } while (0)
    if (IN(0)) { phase0(a, lds, tid, lane, wave); }
    SEAM(0);
    if (IN(1)) {
        rescale_rows_fp8(ws + WS_WIN8, (const signed char*)(ws + WS_ETAB_IN), (float*)(ws + WS_SWIN), (const unsigned*)(ws + WS_CTL + CTL_WIMAX), NP, 1.f / XQ_SCALE, lane, wave);
        if constexpr (F8N < NP) {
            pg8::Gemm g{(const bf16*)(ws + WS_XB), (const bf16*)(ws + WS_WIN), T, NP - F8N, D}; pg8::StaticOrderSkip S; S.init(T, NP - F8N, (int)gridDim.x, (int)blockIdx.x); S.s0 = F8C0 / 256; S.sn = F8N / 256;
            EpiBf16 E{(bf16*)(ws + WS_PROJ), NP};
            pg8::gemm_phase<EpiBf16, pg8::StaticOrderSkip, true, true>(lds, g, S, E);
        }
        xcd_barrier(xbar);
        {
            pg8::Gemm g{(const bf16*)(ws + WS_XQ8), (const bf16*)(ws + WS_WIN8), T, F8N, D}; pg8::StaticOrder S; S.init(T, F8N, (int)gridDim.x, (int)blockIdx.x);
            EpiBf16Res E{(bf16*)(ws + WS_PROJ) + F8C0, nullptr, NP, 0.f, (const float*)(ws + WS_SWIN)};
            pg8::gemm_phase<EpiBf16Res, pg8::StaticOrder, true, true, true>(lds, g, S, E);
        }
    }
    int lane1; asm volatile("v_mbcnt_lo_u32_b32 %0, -1, 0\n\tv_mbcnt_hi_u32_b32 %0, -1, %0" : "=v"(lane1));
    const int tid1 = (wave * 64 + lane1) & 511;
    SEAM1(1);
    if (IN(2)) { phase_gdn_prep(a, lds, tid1, lane1, wave); }
    LOCAL_SEAM(2);
    if (IN(3)) { phase_gdn_solve(a, lds, lane1, wave); }
    SEAM1(3);
    if (IN(4)) {
        if ((int)blockIdx.x < NB * GH) phase_gdn_scan(a, lds, lane1, wave);
        if ((int)gridDim.x <= NB * GH) p0_tables(a, lds, lane1, wave, 0, (int)gridDim.x, 0, TBL_GROUPS);
        else if ((int)blockIdx.x >= NB * GH) p0_tables(a, lds, lane1, wave, NB * GH, (int)gridDim.x - NB * GH, 0, TBL_GROUPS);
    }
    SEAM1(4);
    if (IN(5)) {
        pg8::Gemm g{(const bf16*)(ws + WS_CAT), (const bf16*)(ws + WS_WOUT8), T, D, D}; pg8::StaticOrder S; S.init(T, D, (int)gridDim.x, (int)blockIdx.x);
        EpiBf16Res E{(bf16*)(ws + WS_PRE1), a.in[0], D, ALPHA, (const float*)(ws + WS_SWOUT)};
        pg8::gemm_phase<EpiBf16Res, pg8::StaticOrder, true, false, true>(lds, g, S, E, tid1);
    }
    int lane2; asm volatile("v_mbcnt_lo_u32_b32 %0, -1, 0\n\tv_mbcnt_hi_u32_b32 %0, -1, %0" : "=v"(lane2));
    const int tid2 = (wave * 64 + lane2) & 511;
    SEAM2(5);
    if (IN(6)) { phase_ln1(a, lane2, wave); }
    SEAM2(6);
    if (IN(7)) {
        pg8::Gemm g{(const bf16*)(ws + WS_X1B), (const bf16*)(ws + WS_WQ), T, NQ, D}; pg8::StaticOrder S; S.init(T, NQ, (int)gridDim.x, (int)blockIdx.x);
        EpiBf16 E{(bf16*)(ws + WS_QPB), NQ};
        pg8::gemm_phase<EpiBf16, pg8::StaticOrder, true, true>(lds, g, S, E, tid2);
    }
    SEAM2(7);
    if (IN(8)) { phase_route(a, lane2, wave); }
    LOCAL_SEAM(8);
    if (IN(9)) { phase_expert_down<0>(a, lane2, wave); }
    LOCAL_SEAM(9);
    if (IN(10)) { phase_expert_up<0>(a, lds, lane2, wave); }
#undef IN
#undef SEAM
}

static int g_grid = 0;
static void launch_mk(const Args& base, int lo, int hi, hipStream_t stream) {
    Args a = base; a.ph_lo = lo; a.ph_hi = hi;
    void* params[] = {&a};
    hipError_t e = hipLaunchCooperativeKernel((const void*)mk, dim3(g_grid), dim3(NTHREADS), params, LDS_BYTES, stream);
    if (e != hipSuccess) fprintf(stderr, "kernel_launch: cooperative launch [%d,%d) failed: %s (grid %d)\n", lo, hi, hipGetErrorString(e), g_grid);
}

extern "C" void kernel_launch(void* const* d_in, const int* in_sizes, int n_in, void* d_out, int out_size, void* d_ws, size_t ws_size,
                              hipStream_t stream) {
    (void)in_sizes; (void)n_in; (void)out_size;
    if (!g_grid) {
        int dev = 0, cus = 0, per_cu = 0;
        hipGetDevice(&dev);
        hipDeviceGetAttribute(&cus, hipDeviceAttributeMultiprocessorCount, dev);
        hipFuncSetAttribute((const void*)mk, hipFuncAttributeMaxDynamicSharedMemorySize, LDS_BYTES);
        hipOccupancyMaxActiveBlocksPerMultiprocessor(&per_cu, (const void*)mk, NTHREADS, LDS_BYTES);
        if (per_cu < 1) { fprintf(stderr, "kernel_launch: occupancy query says %d blocks/CU\n", per_cu); per_cu = 1; }
        g_grid = cus * 1;
        if (ws_size < WS_END) fprintf(stderr, "kernel_launch: workspace too small: %zu < %zu\n", ws_size, (size_t)WS_END);
    }
    Args a{};
    for (int i = 0; i < 16; ++i) a.in[i] = (const float*)d_in[i];
    a.out = (float*)d_out; a.ws = (unsigned char*)d_ws; a.ph_lo = 0; a.ph_hi = 0;
    unsigned char* ws = (unsigned char*)d_ws;

    (void)hipMemsetAsync(d_ws, 0, CTL_BYTES, stream);
    launch_mk(a, 0, 11, stream);
}
```

```cpp
#include <hip/hip_runtime.h>
#include <hip/hip_cooperative_groups.h>
#include <stdint.h>
#include <cstdio>
namespace cg = cooperative_groups;

namespace cfg {
constexpr int D = 4096, NB = 4, S = 2048, T = NB * S;
constexpr int GH = 16, GD = 128, GW = 2048;
constexpr int NIN = 14368;
constexpr int NP = 14336;
constexpr int Q0 = 0, K0 = 2048, V0 = 4096, Z0 = 6144, BETA0 = 8192, A0 = 8208;
constexpr int PGB0 = 8192, PGC0 = 10240, PH0 = 12288;
constexpr int PH = 8, PK = 16, PN = 128, PQ = 256;
constexpr int NQ = PH * PQ;
constexpr int NE = 16384;
constexpr float ALPHA = 1.189207115002721f;
constexpr float LN_EPS = 1e-5f, RMS_EPS = 1e-6f;
}
using namespace cfg;
namespace pg8 {
#define PG8_LAS __attribute__((address_space(3)))
typedef unsigned short bf16_t;
typedef short bf16x8 __attribute__((ext_vector_type(8)));
typedef float f32x4 __attribute__((ext_vector_type(4)));
typedef unsigned u32x4 __attribute__((ext_vector_type(4)));
constexpr int BM = 256, BK = 64, HALF = 128, HTB = HALF * BK * 2  , STAGE_BYTES = 8 * HTB, NXCD = 8, WGM = 4;

__host__ __device__ __forceinline__ int lds_byte(int r, int c) { const int st = (r >> 4) * 2 + (c >> 5), rr = r & 15, cc = c & 31, ob = rr * 64 + cc * 2; return st * 1024 + (ob ^ (((ob >> 9) & 1) << 5)); }
__host__ __device__ __forceinline__ void stage_rc(int b, int& R, int& C) { const int st = b / 1024, sb = b % 1024, swz = sb ^ (((sb >> 9) & 1) << 5); R = (st >> 1) * 16 + swz / 64; C = (st & 1) * 32 + (swz % 64) / 2; }
__host__ __device__ __forceinline__ int perm32(int rho) { const int n = rho >> 4, i = rho & 15; return 8 * (i >> 2) + 4 * n + (i & 3); }

struct Unit { int pm, pn; };
struct Gemm { const bf16_t* A; const bf16_t* Bt; int M, N, K; };

struct StaticOrder {
    int nM, nN, nwg, G, c;
    __host__ __device__ void init(int M, int N, int G_, int c_) { nM = M / BM; nN = N / BM; nwg = nM * nN; G = G_; c = c_; }
    __host__ __device__ bool next(int i, Unit& u) const {
        const long L = (long)i * G + c; if (L >= nwg) return false;
        int wgid = (int)L; { const int q = nwg / NXCD, r = nwg % NXCD, xcd = wgid % NXCD, off = wgid / NXCD; wgid = (xcd < r ? xcd * (q + 1) : r * (q + 1) + (xcd - r) * q) + off; }
        const int nig = WGM * nN, gid = wgid / nig, fm = gid * WGM, gsz = (nM - fm) < WGM ? (nM - fm) : WGM;
        u.pm = fm + ((wgid % nig) % gsz); u.pn = (wgid % nig) / gsz; return true;
    }
    __device__ __forceinline__ void a_ready(const Unit&) const {}
    __device__ __forceinline__ void done(const Unit&) const {}
};
struct StaticOrderSkip : StaticOrder {
    int s0, sn;
    __host__ __device__ bool next(int i, Unit& u) const { if (!StaticOrder::next(i, u)) return false; if (u.pn >= s0) u.pn += sn; return true; }
};
__device__ __forceinline__ unsigned cvt_pk_bf16(float lo, float hi) { unsigned r; asm volatile("v_cvt_pk_bf16_f32 %0, %1, %2" : "=v"(r) : "v"(lo), "v"(hi)); return r; }
typedef float f32x2 __attribute__((ext_vector_type(2)));
typedef int i32x8 __attribute__((ext_vector_type(8)));
template <class Epi, class Sched, bool ALIGN_EPI = false, bool SP2 = false, bool F8 = false>
__device__ __forceinline__ void gemm_phase(PG8_LAS unsigned char* lds, const Gemm g, const Sched& S, const Epi& E, int tid_in = -1) {
    const int tid = tid_in < 0 ? (int)threadIdx.x : tid_in, wid = __builtin_amdgcn_readfirstlane(tid >> 6), lane = tid & 63, wr = wid >> 2, wc = wid & 3, fr = lane & 15, fq = lane >> 4;
    const int K = F8 ? g.K / 2 : g.K, nt = K / BK;
    unsigned voffA[2], voffB[2];
#pragma unroll
    for (int i = 0; i < 2; ++i) { int R, C; stage_rc(tid * 16 + i * 8192, R, C); const int Rb = Epi::PERM ? ((R & ~31) + perm32(R & 31)) : R;
        voffA[i] = (unsigned)(R * K + C) * 2u; voffB[i] = (unsigned)(Rb * K + C) * 2u; }
    const size_t kstep = (size_t)(BK * 2);
    const size_t hstep = (size_t)HALF * K * 2;
    const size_t tstep = 2 * hstep;
    const unsigned ldsw = (unsigned)wid * 1024u;
    const int aoff = lds_byte(wr * 64 + fr, F8 ? fq * 16 : fq * 8), boff = lds_byte(wc * 32 + fr, F8 ? fq * 16 : fq * 8);
    const int aoff1 = aoff + (F8 ? 16 : 1024), boff1 = boff + (F8 ? 16 : 1024);
#define PG8_SA(b, h) (((b) * 2 + (h)) * HTB)
#define PG8_SB(b, h) ((4 + (b) * 2 + (h)) * HTB)
    const __amdgpu_buffer_rsrc_t rsA = __builtin_amdgcn_make_buffer_rsrc((void*)g.A, 0, 0x7fffffff, 0x00020000), rsB = __builtin_amdgcn_make_buffer_rsrc((void*)g.Bt, 0, 0x7fffffff, 0x00020000);
#define PG8_STAGE(bufoff, gbase, voff) do { const bool isA_ = ((const unsigned*)(voff) == (const unsigned*)voffA); \
        const int so_ = (int)((const char*)(gbase) - (const char*)(isA_ ? (const void*)g.A : (const void*)g.Bt)); \
        _Pragma("unroll") for (int _i = 0; _i < 2; ++_i)        \
        __builtin_amdgcn_raw_ptr_buffer_load_lds(isA_ ? rsA : rsB, (PG8_LAS unsigned*)(lds + (bufoff) + ldsw + _i * 8192), 16, (int)(voff)[0], so_ + _i * 64 * K * 2, 0, 0); } while (0)
#define PG8_LDA(dst, b, h) do { _Pragma("unroll") for (int m = 0; m < 4; ++m) dst[m] = __builtin_shufflevector(*(const PG8_LAS bf16x8*)(lds + PG8_SA(b, h) + aoff + m * 2048), *(const PG8_LAS bf16x8*)(lds + PG8_SA(b, h) + aoff1 + m * 2048), 0, 1, 2, 3, 4, 5, 6, 7, 8, 9, 10, 11, 12, 13, 14, 15); } while (0)
#define PG8_LDB(dst, b, h) do { _Pragma("unroll") for (int n = 0; n < 2; ++n) dst[n] = __builtin_shufflevector(*(const PG8_LAS bf16x8*)(lds + PG8_SB(b, h) + boff + n * 2048), *(const PG8_LAS bf16x8*)(lds + PG8_SB(b, h) + boff1 + n * 2048), 0, 1, 2, 3, 4, 5, 6, 7, 8, 9, 10, 11, 12, 13, 14, 15); } while (0)
#define PG8_MMA(ai, bj, At, Bt) do { __builtin_amdgcn_s_setprio(1); _Pragma("unroll") for (int m = 0; m < 4; ++m) _Pragma("unroll") for (int n = 0; n < 2; ++n) { \
        if constexpr (F8) { \
            acc[ai][bj][m][n] = __builtin_amdgcn_mfma_scale_f32_16x16x128_f8f6f4(__builtin_bit_cast(i32x8, Bt[n]), __builtin_bit_cast(i32x8, At[m]), acc[ai][bj][m][n], 0, 0, 0, 0x7f7f7f7f, 0, 0x7f7f7f7f); \
        } else { \
            acc[ai][bj][m][n] = __builtin_amdgcn_mfma_f32_16x16x32_bf16(__builtin_shufflevector(Bt[n], Bt[n], 0, 1, 2, 3, 4, 5, 6, 7), __builtin_shufflevector(At[m], At[m], 0, 1, 2, 3, 4, 5, 6, 7), acc[ai][bj][m][n], 0, 0, 0); \
            acc[ai][bj][m][n] = __builtin_amdgcn_mfma_f32_16x16x32_bf16(__builtin_shufflevector(Bt[n], Bt[n], 8, 9, 10, 11, 12, 13, 14, 15), __builtin_shufflevector(At[m], At[m], 8, 9, 10, 11, 12, 13, 14, 15), acc[ai][bj][m][n], 0, 0, 0); } } \
        __builtin_amdgcn_s_setprio(0); } while (0)
#define PG8_WAIT_V(n) asm volatile("s_waitcnt vmcnt(" #n ")" ::: "memory")
#define PG8_WAIT_L(n) asm volatile("s_waitcnt lgkmcnt(" #n ")" ::: "memory")
#define PG8_BAR __builtin_amdgcn_s_barrier()
#define PG8_SCHED __builtin_amdgcn_sched_barrier(0)
    Unit cur, nxt; int ui = 0;
    if (!S.next(0, cur)) return;
    f32x4 acc[2][2][4][2];
#pragma unroll
    for (int a = 0; a < 2; ++a)
#pragma unroll
        for (int b = 0; b < 2; ++b)
#pragma unroll
            for (int m = 0; m < 4; ++m)
#pragma unroll
                for (int n = 0; n < 2; ++n) acc[a][b][m][n] = (f32x4){0.f, 0.f, 0.f, 0.f};
    typedef short s16x16 __attribute__((ext_vector_type(16)));
    s16x16 At[4], B0[2], B1[2];
    const char* cA = (const char*)g.A + (size_t)cur.pm * tstep; const char* cB = (const char*)g.Bt + (size_t)cur.pn * tstep;
    S.a_ready(cur);
    if constexpr (SP2) {
        PG8_STAGE(PG8_SB(0, 0), cB, voffB); PG8_STAGE(PG8_SB(0, 1), cB + hstep, voffB); PG8_STAGE(PG8_SA(0, 0), cA, voffA); PG8_STAGE(PG8_SA(0, 1), cA + hstep, voffA);
        if (wr == 1) PG8_BAR;
        PG8_WAIT_V(2); PG8_BAR;
        PG8_STAGE(PG8_SB(1, 0), cB + kstep, voffB); PG8_STAGE(PG8_SA(1, 0), cA + kstep, voffA); PG8_STAGE(PG8_SB(1, 1), cB + hstep + kstep, voffB);
        PG8_WAIT_V(6); PG8_BAR;
    } else {
        PG8_STAGE(PG8_SB(0, 0), cB, voffB); PG8_STAGE(PG8_SA(0, 0), cA, voffA); PG8_STAGE(PG8_SB(0, 1), cB + hstep, voffB); PG8_STAGE(PG8_SA(0, 1), cA + hstep, voffA);
        if (wr == 1) PG8_BAR;
        PG8_WAIT_V(4); PG8_BAR;
        PG8_STAGE(PG8_SB(1, 0), cB + kstep, voffB); PG8_STAGE(PG8_SA(1, 0), cA + kstep, voffA); PG8_STAGE(PG8_SB(1, 1), cB + hstep + kstep, voffB);
        PG8_WAIT_V(6); PG8_BAR;
    }
    for (;;) {
        const bool has_next = S.next(ui + 1, nxt);
        const char* nA = has_next ? (const char*)g.A + (size_t)nxt.pm * tstep : cA; const char* nB = has_next ? (const char*)g.Bt + (size_t)nxt.pn * tstep : cB;
        for (int t = 0; t < nt; t += 2) {
            const bool last = (t == nt - 2);
            const char* a1 = cA + (size_t)(t + 1) * kstep;
            const char* a2 = last ? nA : cA + (size_t)(t + 2) * kstep; const char* b2 = last ? nB : cB + (size_t)(t + 2) * kstep;
            const char* a3 = a2 + kstep; const char* b3 = b2 + kstep;
            if (last && has_next) S.a_ready(nxt);
            if constexpr (SP2) {
            PG8_LDB(B0, 0, 0); PG8_LDB(B1, 0, 1); PG8_SCHED; PG8_LDA(At, 0, 0); PG8_STAGE(PG8_SA(1, 1), a1 + hstep, voffA);
            PG8_WAIT_V(8); PG8_WAIT_L(0); PG8_BAR; PG8_MMA(0, 0, At, B0); PG8_MMA(0, 1, At, B1); PG8_BAR; PG8_SCHED;
            PG8_LDA(At, 0, 1); PG8_STAGE(PG8_SB(0, 0), b2, voffB); PG8_STAGE(PG8_SB(0, 1), b2 + hstep, voffB); PG8_STAGE(PG8_SA(0, 0), a2, voffA);
            PG8_WAIT_V(8); PG8_WAIT_L(0); PG8_BAR; PG8_MMA(1, 0, At, B0); PG8_MMA(1, 1, At, B1); PG8_BAR; PG8_SCHED;
            PG8_LDB(B0, 1, 0); PG8_LDB(B1, 1, 1); PG8_SCHED; PG8_LDA(At, 1, 0); PG8_STAGE(PG8_SA(0, 1), a2 + hstep, voffA);
            PG8_WAIT_V(8); PG8_WAIT_L(0); PG8_BAR; PG8_MMA(0, 0, At, B0); PG8_MMA(0, 1, At, B1); PG8_BAR; PG8_SCHED;
            PG8_LDA(At, 1, 1); PG8_STAGE(PG8_SB(1, 0), b3, voffB); PG8_STAGE(PG8_SB(1, 1), b3 + hstep, voffB); PG8_STAGE(PG8_SA(1, 0), a3, voffA);
            PG8_WAIT_V(8); PG8_WAIT_L(0); PG8_BAR; PG8_MMA(1, 0, At, B0); PG8_MMA(1, 1, At, B1); PG8_BAR; PG8_SCHED;
            } else {
            PG8_LDB(B0, 0, 0); PG8_SCHED; PG8_LDA(At, 0, 0); PG8_STAGE(PG8_SA(1, 1), a1 + hstep, voffA);
            PG8_WAIT_L(8); PG8_BAR; PG8_WAIT_L(0); PG8_MMA(0, 0, At, B0); PG8_BAR; PG8_SCHED;
            PG8_LDB(B1, 0, 1); PG8_STAGE(PG8_SB(0, 0), b2, voffB);
            PG8_BAR; PG8_WAIT_L(0); PG8_MMA(0, 1, At, B1); PG8_BAR;
            PG8_LDA(At, 0, 1); PG8_STAGE(PG8_SA(0, 0), a2, voffA);
            PG8_BAR; PG8_WAIT_L(0); PG8_MMA(1, 0, At, B0); PG8_BAR; PG8_SCHED;
            PG8_STAGE(PG8_SB(0, 1), b2 + hstep, voffB);
            PG8_WAIT_V(6); PG8_BAR; PG8_MMA(1, 1, At, B1); PG8_BAR;
            PG8_LDB(B0, 1, 0); PG8_SCHED; PG8_LDA(At, 1, 0); PG8_STAGE(PG8_SA(0, 1), a2 + hstep, voffA);
            PG8_WAIT_L(8); PG8_BAR; PG8_WAIT_L(0); PG8_MMA(0, 0, At, B0); PG8_BAR; PG8_SCHED;
            PG8_LDB(B1, 1, 1); PG8_STAGE(PG8_SB(1, 0), b3, voffB);
            PG8_BAR; PG8_WAIT_L(0); PG8_MMA(0, 1, At, B1); PG8_BAR;
            PG8_LDA(At, 1, 1); PG8_STAGE(PG8_SA(1, 0), a3, voffA);
            PG8_BAR; PG8_WAIT_L(0); PG8_MMA(1, 0, At, B0); PG8_BAR; PG8_SCHED;
            PG8_STAGE(PG8_SB(1, 1), b3 + hstep, voffB);
            PG8_WAIT_V(6); PG8_BAR; PG8_MMA(1, 1, At, B1); PG8_BAR;
            }
        }
        if constexpr (ALIGN_EPI) { if (wr == 0) PG8_BAR; }
        if constexpr (!Epi::AFTER_DRAIN) { E(acc, cur, wr, wc, fr, fq); S.done(cur); }
        if (!has_next) break;
#pragma unroll
        for (int a = 0; a < 2; ++a)
#pragma unroll
            for (int b = 0; b < 2; ++b)
#pragma unroll
                for (int m = 0; m < 4; ++m)
#pragma unroll
                    for (int n = 0; n < 2; ++n) acc[a][b][m][n] = (f32x4){0.f, 0.f, 0.f, 0.f};
        cur = nxt; cA = nA; cB = nB; ++ui;
        if constexpr (ALIGN_EPI) { if (wr == 1) PG8_BAR; }
    }
    PG8_WAIT_V(0);
    if constexpr (!ALIGN_EPI) { if (wr == 0) PG8_BAR; }
    PG8_BAR;
    if constexpr (Epi::AFTER_DRAIN) { E.fused(acc, cur, wr, wc, fr, fq, lds, wid, lane); S.done(cur); }
#undef PG8_SA
#undef PG8_SB
#undef PG8_STAGE
#undef PG8_LDA
#undef PG8_LDB
#undef PG8_MMA
#undef PG8_WAIT_V
#undef PG8_WAIT_L
#undef PG8_BAR
#undef PG8_SCHED
}
}

#define LAS __attribute__((address_space(3)))
typedef unsigned short bf16;
typedef unsigned v4u __attribute__((ext_vector_type(4)));
typedef float f32x4 __attribute__((ext_vector_type(4)));
typedef float f32x16 __attribute__((ext_vector_type(16)));
typedef short bf16x8 __attribute__((ext_vector_type(8)));
typedef float f32x2v __attribute__((ext_vector_type(2)));
#define LDS_WAIT() asm volatile("s_waitcnt lgkmcnt(0)" ::: "memory")
#define VM_WAIT() asm volatile("s_waitcnt vmcnt(0)" ::: "memory")
__device__ __forceinline__ unsigned f2bf(float f) { unsigned u = __builtin_bit_cast(unsigned, f); return (u + 0x7fffu + ((u >> 16) & 1u)) >> 16; }
__device__ __forceinline__ unsigned pk2(float lo, float hi) { return f2bf(lo) | (f2bf(hi) << 16); }
__device__ __forceinline__ float clamp448(float v) { return fminf(fmaxf(v, -448.f), 448.f); }
__device__ __forceinline__ unsigned pk4_fp8(float a0, float a1, float a2, float a3) { int p = 0; p = __builtin_amdgcn_cvt_pk_fp8_f32(clamp448(a0), clamp448(a1), p, false); p = __builtin_amdgcn_cvt_pk_fp8_f32(clamp448(a2), clamp448(a3), p, true); return (unsigned)p; }
__device__ __forceinline__ float bf2f(unsigned short b) { return __builtin_bit_cast(float, (unsigned)b << 16); }
__device__ __forceinline__ float bflo(unsigned w) { return __builtin_bit_cast(float, w << 16); }
__device__ __forceinline__ float bfhi(unsigned w) { return __builtin_bit_cast(float, w & 0xffff0000u); }

__device__ __forceinline__ float wave_sum(float v) {
#pragma unroll
    for (int o = 1; o < 64; o <<= 1) v += __shfl_xor(v, o);
    return v;
}
__device__ __forceinline__ float silu_f(float x) { return x * __builtin_amdgcn_rcpf(1.f + __expf(-x)); }
__device__ __forceinline__ float sigmoid_f(float x) { return 1.f / (1.f + expf(-x)); }
__device__ __forceinline__ float softplus_f(float x) { return x > 20.f ? x : log1pf(expf(x)); }
__device__ __forceinline__ float gelu_f(float z) { return 0.5f * z * (1.f + erff(z * 0.7071067811865476f)); }

constexpr size_t al256(size_t x) { return (x + 255) & ~(size_t)255; }
constexpr size_t WS_CTL = 0;
constexpr size_t CTL_WIMAX = 65536;
constexpr size_t CTL_WOMAX = 32768;
constexpr size_t CTL_TBLQ = 126976;
constexpr size_t CTL_BYTES = 131072;
constexpr size_t WS_XB = WS_CTL + CTL_BYTES;
constexpr size_t WS_WIN = WS_XB + al256((size_t)T * D * 2);
constexpr size_t WS_WOUT = WS_WIN + al256((size_t)NP * D * 2);
constexpr size_t WS_WQ = WS_WOUT + al256((size_t)D * D * 2);
constexpr size_t WS_BRAW = WS_WQ + al256((size_t)NQ * D * 2);
constexpr size_t WS_PROJ = WS_BRAW + al256((size_t)T * 32 * 4);
constexpr size_t WS_CAT = WS_PROJ + al256((size_t)T * NP * 2);
constexpr size_t WS_PRE1 = WS_CAT + al256((size_t)T * D * 2);
constexpr size_t WS_X1 = WS_PRE1 + al256((size_t)T * D * 4);
constexpr int F8G0 = 0, F8G1 = 7;
constexpr int F8C0 = F8G0 * 2048, F8C1 = F8G1 * 2048, F8N = F8C1 - F8C0;
constexpr float XQ_SCALE = 16.f;
constexpr size_t WS_XQ8 = WS_X1;
constexpr size_t WS_WIN8 = WS_XQ8 + al256((size_t)T * D);
constexpr size_t WS_SWIN = WS_WIN8 + al256((size_t)F8N * D);
static_assert(WS_SWIN + F8N * 4 <= WS_X1 + (size_t)T * D * 4, "fp8 in-projection operands must fit in the X1 region");
constexpr size_t WS_ETAB_IN = WS_WIN;
constexpr size_t WS_ETAB_OUT = WS_ETAB_IN + al256((size_t)NP * 64);
static_assert(F8G0 == 0 && F8G1 == 7, "the fp8 transposes cover the whole in-projection");
constexpr size_t WS_X1B = WS_X1 + al256((size_t)T * D * 4);
constexpr size_t WS_QPB = WS_X1B + al256((size_t)T * D * 2);
constexpr size_t WS_KEYSB = WS_QPB + al256((size_t)T * NQ * 2);
constexpr size_t WS_EIDX = WS_KEYSB + al256((size_t)PH * 2 * PN * 128 * 2);
constexpr size_t WS_EGATE = WS_EIDX + al256((size_t)T * PH * PK * 4);
constexpr size_t WS_WD8 = WS_EGATE + al256((size_t)T * PH * PK * 4);
constexpr size_t WS_WU8 = WS_WD8 + al256((size_t)NE * D);
constexpr size_t WS_SD = WS_WU8 + al256((size_t)NE * D);
constexpr size_t WS_SU = WS_SD + al256((size_t)NE * 4);
constexpr size_t WS_WOUT8 = WS_SU + al256((size_t)NE * 4);
constexpr size_t WS_SWOUT = WS_WOUT8 + al256((size_t)D * D);
constexpr size_t WS_ABUF = WS_SWOUT + al256((size_t)D * 4);
constexpr size_t WS_END = WS_ABUF + al256((size_t)T * 128 * 4);
static_assert(WS_END <= (size_t)1024 * 1024 * 1024, "workspace");

constexpr int NWAVES = 8, NTHREADS = 512;
constexpr int TBL_GROUPS = 2 * NE / 8;
constexpr int LDS_BYTES = 147456;

struct EpiBf16 {
    static constexpr bool PERM = true, AFTER_DRAIN = false;
    bf16* O; int ldc;
    __device__ __forceinline__ void operator()(const pg8::f32x4 (&acc)[2][2][4][2], const pg8::Unit& u, int wr, int wc, int fr, int fq) const {
        const int row0 = u.pm * 256 + wr * 64 + fr, col0 = u.pn * 256 + wc * 32 + 8 * fq;
#pragma unroll
        for (int ai = 0; ai < 2; ++ai)
#pragma unroll
            for (int m = 0; m < 4; ++m) { bf16* rowp = O + (size_t)(row0 + ai * 128 + m * 16) * ldc + col0;
#pragma unroll
                for (int bj = 0; bj < 2; ++bj) { const pg8::f32x4 v0 = acc[ai][bj][m][0], v1 = acc[ai][bj][m][1];
                    pg8::u32x4 w; w.x = pg8::cvt_pk_bf16(v0[0], v0[1]); w.y = pg8::cvt_pk_bf16(v0[2], v0[3]); w.z = pg8::cvt_pk_bf16(v1[0], v1[1]); w.w = pg8::cvt_pk_bf16(v1[2], v1[3]);
                    *(pg8::u32x4*)(rowp + bj * 128) = w; } }
    }
};
struct EpiBf16Res {
    static constexpr bool PERM = false, AFTER_DRAIN = false;
    bf16* C; const float* R; int ldc; float alpha; const float* cs;
    __device__ __forceinline__ void operator()(const pg8::f32x4 (&acc)[2][2][4][2], const pg8::Unit& u, int wr, int wc, int fr, int fq) const {
        { int ln; asm volatile("v_mbcnt_lo_u32_b32 %0, -1, 0\n\tv_mbcnt_hi_u32_b32 %0, -1, %0" : "=v"(ln)); fr = ln & 15; fq = ln >> 4; }
        const int row0 = u.pm * 256 + wr * 64 + fr, col0 = u.pn * 256 + wc * 32 + 4 * fq;
#pragma unroll
        for (int ai = 0; ai < 2; ++ai)
#pragma unroll
            for (int m = 0; m < 4; ++m) { const size_t ro = (size_t)(row0 + ai * 128 + m * 16) * ldc + col0;
#pragma unroll
                for (int bj = 0; bj < 2; ++bj)
#pragma unroll
                    for (int n = 0; n < 2; ++n) { const size_t o = ro + bj * 128 + n * 16;
                        pg8::f32x4 v = acc[ai][bj][m][n];
                        if (cs) v = v * *(const pg8::f32x4*)(cs + col0 + bj * 128 + n * 16);
                        if (R) v = v + *(const pg8::f32x4*)(R + o) * alpha;
                        *(unsigned long long*)(C + o) = (unsigned long long)pg8::cvt_pk_bf16(v[0], v[1]) | ((unsigned long long)pg8::cvt_pk_bf16(v[2], v[3]) << 32); }
                asm volatile("" ::: "memory"); }
    }
};

__device__ __forceinline__ void p0_transpose_item(const float* __restrict__ W, int N, int K, int k0, int n0, bf16* WT, int drow0, LAS float* scr, int lane, unsigned* rmax = nullptr) {
#pragma unroll 8
    for (int i = 0; i < 32; ++i) { const int kk = 2 * i + (lane >> 5); scr[kk * 33 + (lane & 31)] = W[(size_t)(k0 + kk) * N + n0 + (lane & 31)]; }
    LDS_WAIT(); asm volatile("" ::: "memory");
    const int c = lane & 7;
#pragma unroll
    for (int j = 0; j < 4; ++j) { const int n = (lane >> 3) + 8 * j; const LAS float* s = scr + (8 * c) * 33 + n;
        v4u o; o.x = pk2(s[0 * 33], s[1 * 33]); o.y = pk2(s[2 * 33], s[3 * 33]); o.z = pk2(s[4 * 33], s[5 * 33]); o.w = pk2(s[6 * 33], s[7 * 33]);
        *(v4u*)(WT + (size_t)(drow0 + n) * K + k0 + 8 * c) = o;
        if (rmax) {
            float mx = fmaxf(fmaxf(fmaxf(fabsf(s[0 * 33]), fabsf(s[1 * 33])), fmaxf(fabsf(s[2 * 33]), fabsf(s[3 * 33]))), fmaxf(fmaxf(fabsf(s[4 * 33]), fabsf(s[5 * 33])), fmaxf(fabsf(s[6 * 33]), fabsf(s[7 * 33]))));
            mx = fmaxf(mx, __shfl_xor(mx, 1)); mx = fmaxf(mx, __shfl_xor(mx, 2)); mx = fmaxf(mx, __shfl_xor(mx, 4));
            if (c == 0) atomicMax(rmax + drow0 + n, __builtin_bit_cast(unsigned, mx)); } }
    LDS_WAIT(); asm volatile("" ::: "memory");
}

__device__ __forceinline__ void p0_transpose_item_f8(const float* __restrict__ W, int N, int K, int k0, int n0, unsigned char* W8T, int drow0, LAS float* scr, int lane, unsigned* rmax, signed char* etab) {
#pragma unroll 8
    for (int i = 0; i < 32; ++i) { const int kk = 2 * i + (lane >> 5); scr[kk * 33 + (lane & 31)] = W[(size_t)(k0 + kk) * N + n0 + (lane & 31)]; }
    LDS_WAIT(); asm volatile("" ::: "memory");
    const int c = lane & 7;
#pragma unroll
    for (int j = 0; j < 4; ++j) { const int n = (lane >> 3) + 8 * j; const LAS float* s = scr + (8 * c) * 33 + n;
        float v[8];
#pragma unroll
        for (int i = 0; i < 8; ++i) v[i] = s[i * 33];
        float mx = fmaxf(fmaxf(fmaxf(fabsf(v[0]), fabsf(v[1])), fmaxf(fabsf(v[2]), fabsf(v[3]))), fmaxf(fmaxf(fabsf(v[4]), fabsf(v[5])), fmaxf(fabsf(v[6]), fabsf(v[7]))));
        mx = fmaxf(mx, __shfl_xor(mx, 1)); mx = fmaxf(mx, __shfl_xor(mx, 2)); mx = fmaxf(mx, __shfl_xor(mx, 4));
        const int e = mx > 0.f ? min(max(__builtin_amdgcn_frexp_expf(mx * (1.f / 448.f)), -100), 100) : -100;
        const float sc = __builtin_amdgcn_ldexpf(1.f, -e);
        *(unsigned long long*)(W8T + (size_t)(drow0 + n) * K + k0 + 8 * c) = (unsigned long long)pk4_fp8(v[0] * sc, v[1] * sc, v[2] * sc, v[3] * sc) | ((unsigned long long)pk4_fp8(v[4] * sc, v[5] * sc, v[6] * sc, v[7] * sc) << 32);
        if (c == 0) { etab[(size_t)(drow0 + n) * (K / 64) + (k0 >> 6)] = (signed char)e; atomicMax(rmax + drow0 + n, __builtin_bit_cast(unsigned, mx)); } }
    LDS_WAIT(); asm volatile("" ::: "memory");
}
__device__ __forceinline__ void rescale_rows_fp8(unsigned char* w8, const signed char* etab, float* sw, const unsigned* rmax, int nrows, float post, int lane, int wave) {
    for (int n = blockIdx.x * NWAVES + wave; n < nrows; n += gridDim.x * NWAVES) {
        const float m = __builtin_bit_cast(float, rmax[n]);
        const int er = m > 0.f ? min(max(__builtin_amdgcn_frexp_expf(m * (1.f / 448.f)), -100), 100) : -100;
        const int sh = er - (int)etab[(size_t)n * 64 + lane];
        if (sh > 0) {
            const float f = __builtin_amdgcn_ldexpf(1.f, -sh);
            v4u* p = (v4u*)(w8 + (size_t)n * D + 64 * lane);
#pragma unroll
            for (int q = 0; q < 4; ++q) { v4u t = p[q];
#pragma unroll
                for (int d = 0; d < 4; ++d) { const f32x2v lo = __builtin_amdgcn_cvt_pk_f32_fp8((int)t[d], false), hi = __builtin_amdgcn_cvt_pk_f32_fp8((int)t[d], true);
                    int o = 0; o = __builtin_amdgcn_cvt_pk_fp8_f32(lo[0] * f, lo[1] * f, o, false); o = __builtin_amdgcn_cvt_pk_fp8_f32(hi[0] * f, hi[1] * f, o, true); t[d] = (unsigned)o; }
                p[q] = t; }
        }
        if (lane == 0) sw[n] = __builtin_amdgcn_ldexpf(1.f, er) * post;
    }
}

__device__ __forceinline__ void quant_rows_fp8(const bf16* wt, unsigned char* w8, float* sw, const unsigned* rmax, int nrows, float post, int lane, int wave) {
    for (int n = blockIdx.x * NWAVES + wave; n < nrows; n += gridDim.x * NWAVES) {
        const float m = __builtin_bit_cast(float, rmax[n]); const float inv = m > 0.f ? 448.f / m : 0.f;
#pragma unroll
        for (int j = 0; j < 4; ++j) {
            const bf16* src = wt + (size_t)n * D + 1024 * j + 16 * lane;
            const v4u a0 = *(const v4u*)src, a1 = *(const v4u*)(src + 8);
            v4u o; o.x = pk4_fp8(bflo(a0.x) * inv, bfhi(a0.x) * inv, bflo(a0.y) * inv, bfhi(a0.y) * inv); o.y = pk4_fp8(bflo(a0.z) * inv, bfhi(a0.z) * inv, bflo(a0.w) * inv, bfhi(a0.w) * inv);
            o.z = pk4_fp8(bflo(a1.x) * inv, bfhi(a1.x) * inv, bflo(a1.y) * inv, bfhi(a1.y) * inv); o.w = pk4_fp8(bflo(a1.z) * inv, bfhi(a1.z) * inv, bflo(a1.w) * inv, bfhi(a1.w) * inv);
            *(v4u*)(w8 + (size_t)n * D + 1024 * j + 16 * lane) = o;
        }
        if (lane == 0) sw[n] = m * (1.f / 448.f) * post;
    }
}

struct Args { const float* in[16]; float* out; unsigned char* ws; int ph_lo, ph_hi; };

__device__ __forceinline__ void phase0(const Args& a, LAS unsigned char* lds, int tid, int lane, int wave) {
    const float* x = a.in[0]; const float* w_in = a.in[1]; const float* w_out = a.in[7]; const float* wq = a.in[10];
    unsigned char* ws = a.ws;
    bf16* xb = (bf16*)(ws + WS_XB); bf16* win_t = (bf16*)(ws + WS_WIN); bf16* wout_t = (bf16*)(ws + WS_WOUT); bf16* wq_t = (bf16*)(ws + WS_WQ);
    float* braw = (float*)(ws + WS_BRAW);
    const int G = gridDim.x, gw = blockIdx.x * NWAVES + wave, NGW = G * NWAVES;
    for (int tt = blockIdx.x; tt < T / 32; tt += G) {
        const int t0 = tt * 32;
        f32x16 acc;
#pragma unroll
        for (int i = 0; i < 16; ++i) acc[i] = 0.f;
        const float* xa = x + (size_t)(t0 + (lane & 31)) * D + 512 * wave + 4 * (lane >> 5);
        const float* wb = w_in + (size_t)(512 * wave + 4 * (lane >> 5)) * NIN + BETA0 + (lane & 31);
        unsigned char* xq = ws + WS_XQ8 + (size_t)(t0 + (lane & 31)) * D + 512 * wave + 8 * (lane >> 5);
#pragma unroll 8
        for (int j2 = 0; j2 < 32; ++j2) {
            unsigned q8[2];
#pragma unroll
            for (int jj = 0; jj < 2; ++jj) { const int j = 2 * j2 + jj;
                const f32x4 v = *(const f32x4*)(xa + 8 * j);
                float b[4];
#pragma unroll
                for (int c = 0; c < 4; ++c) b[c] = wb[(size_t)(8 * j + c) * NIN];
                q8[jj] = pk4_fp8(v[0] * XQ_SCALE, v[1] * XQ_SCALE, v[2] * XQ_SCALE, v[3] * XQ_SCALE);
#pragma unroll
                for (int c = 0; c < 4; ++c) acc = __builtin_amdgcn_mfma_f32_32x32x2f32(v[c], b[c], acc, 0, 0, 0);
            }
            const auto sw = __builtin_amdgcn_permlane32_swap(q8[0], q8[1], false, false);
            *(unsigned long long*)(xq + 16 * j2) = (unsigned long long)sw[0] | ((unsigned long long)sw[1] << 32);
        }
        LAS float* part = (LAS float*)lds;
#pragma unroll
        for (int r = 0; r < 16; ++r) part[(wave * 16 + r) * 64 + lane] = acc[r];
        __syncthreads();
        for (int e = tid; e < 1024; e += NTHREADS) {
            float s = 0.f;
#pragma unroll
            for (int w = 0; w < 8; ++w) s += part[w * 1024 + e];
            const int r = e >> 6, l = e & 63;
            const int row = (r & 3) + 8 * (r >> 2) + 4 * (l >> 5), col = l & 31;
            braw[(size_t)(t0 + row) * 32 + col] = s;
        }
        __syncthreads();
    }
    {
        const float* keys = a.in[11]; bf16* keysb = (bf16*)(ws + WS_KEYSB);
        const size_t n8 = (size_t)PH * 2 * PN * 128 / 8;
        for (size_t i = (size_t)blockIdx.x * NTHREADS + tid; i < n8; i += (size_t)G * NTHREADS) {
            const f32x4 v0 = *(const f32x4*)(keys + i * 8), v1 = *(const f32x4*)(keys + i * 8 + 4);
            v4u o; o.x = pk2(v0[0], v0[1]); o.y = pk2(v0[2], v0[3]); o.z = pk2(v1[0], v1[1]); o.w = pk2(v1[2], v1[3]);
            *(v4u*)(keysb + i * 8) = o;
        }
    }
    {
        LAS float* scr = (LAS float*)(lds + wave * 16384);
        constexpr int NB_IN = NIN / 32;
        constexpr int I_IN = (D / 64) * NB_IN, I_OUT = (D / 64) * (D / 32), I_Q = (D / 64) * (NQ / 32);
        for (int it = gw; it < I_IN + I_OUT + I_Q; it += NGW) {
            int r = it;
            if (r < I_IN) { const int kb = r / NB_IN, nb = r % NB_IN; if (nb == 256) continue;
                p0_transpose_item_f8(w_in, NIN, D, 64 * kb, 32 * nb, ws + WS_WIN8, 32 * (nb > 256 ? nb - 1 : nb), scr, lane, (unsigned*)(ws + WS_CTL + CTL_WIMAX), (signed char*)(ws + WS_ETAB_IN)); continue; }
            r -= I_IN;
            if (r < I_OUT) { const int kb = r / (D / 32), nb = r % (D / 32); p0_transpose_item_f8(w_out, D, D, 64 * kb, 32 * nb, ws + WS_WOUT8, 32 * nb, scr, lane, (unsigned*)(ws + WS_CTL + CTL_WOMAX), (signed char*)(ws + WS_ETAB_OUT)); continue; }
            r -= I_OUT;
            { const int kb = r / (NQ / 32), nb = r % (NQ / 32); p0_transpose_item(wq, NQ, D, 64 * kb, 32 * nb, wq_t, 32 * nb, scr, lane); }
        }
    }
    __syncthreads();
}

__device__ __forceinline__ void phase_ln1(const Args& a, int lane, int wave) {
    const bf16* pre = (const bf16*)(a.ws + WS_PRE1); bf16* x1b = (bf16*)(a.ws + WS_X1B);
    const float* g = a.in[8]; const float* bb = a.in[9];
    const int gw = blockIdx.x * NWAVES + wave, NGW = gridDim.x * NWAVES;
    for (int m = gw; m < T; m += NGW) {
        const v4u* xr = (const v4u*)(pre + (size_t)m * D) + lane;
        v4u raw[8]; f32x4 v[16]; float s = 0.f;
#pragma unroll
        for (int j = 0; j < 8; ++j) raw[j] = __builtin_nontemporal_load(xr + 64 * j);
#pragma unroll
        for (int j = 0; j < 8; ++j) { v[2 * j] = (f32x4){bflo(raw[j].x), bfhi(raw[j].x), bflo(raw[j].y), bfhi(raw[j].y)}; v[2 * j + 1] = (f32x4){bflo(raw[j].z), bfhi(raw[j].z), bflo(raw[j].w), bfhi(raw[j].w)};
            s += ((v[2 * j][0] + v[2 * j][1]) + (v[2 * j][2] + v[2 * j][3])) + ((v[2 * j + 1][0] + v[2 * j + 1][1]) + (v[2 * j + 1][2] + v[2 * j + 1][3])); }
        const float mean = wave_sum(s) * (1.f / D); float s2 = 0.f;
#pragma unroll
        for (int j = 0; j < 16; ++j) { v[j] = v[j] - mean; s2 += (v[j][0] * v[j][0] + v[j][1] * v[j][1]) + (v[j][2] * v[j][2] + v[j][3] * v[j][3]); }
        const float rstd = rsqrtf(wave_sum(s2) * (1.f / D) + LN_EPS);
#pragma unroll
        for (int j = 0; j < 8; ++j) {
            const int c = (lane + 64 * j) * 8;
            const f32x4 g0 = *(const f32x4*)(g + c), g1 = *(const f32x4*)(g + c + 4), b0 = *(const f32x4*)(bb + c), b1 = *(const f32x4*)(bb + c + 4);
            const f32x4 o0 = v[2 * j] * rstd * g0 + b0, o1 = v[2 * j + 1] * rstd * g1 + b1;
            v4u o; o.x = pk2(o0[0], o0[1]); o.y = pk2(o0[2], o0[3]); o.z = pk2(o1[0], o1[1]); o.w = pk2(o1[2], o1[3]);
            *(v4u*)(x1b + (size_t)m * D + c) = o;
        }
    }
}


typedef __bf16 bf2_t __attribute__((ext_vector_type(2)));
typedef float f2_t __attribute__((ext_vector_type(2)));
__device__ __forceinline__ unsigned pkbf(float lo, float hi) { f2_t v = {lo, hi}; return __builtin_bit_cast(unsigned, __builtin_convertvector(v, bf2_t)); }
__device__ __forceinline__ int f2ord(float f) { const int i = __builtin_bit_cast(int, f); return i ^ ((i >> 31) & 0x7fffffff); }
__device__ __forceinline__ float ord2f(int i) { return __builtin_bit_cast(float, i ^ ((i >> 31) & 0x7fffffff)); }
__device__ __forceinline__ int imax(int a, int b) { return a > b ? a : b; }
__device__ __forceinline__ int imin(int a, int b) { return a < b ? a : b; }
template <int O, int N>
__device__ __forceinline__ void bitonic_sort16(int (&v)[N]) {
#pragma unroll
    for (int k = 2; k <= 16; k <<= 1)
#pragma unroll
        for (int j = k >> 1; j > 0; j >>= 1)
#pragma unroll
            for (int i = 0; i < 16; ++i) {
                const int l = i ^ j;
                if (l > i) {
                    const int a = v[O + i], b = v[O + l], mx = imax(a, b), mn = imin(a, b);
                    if ((i & k) == 0) { v[O + i] = mx; v[O + l] = mn; } else { v[O + i] = mn; v[O + l] = mx; }
                }
            }
}
__device__ __forceinline__ void bitonic_merge16(int (&v)[16]) {
#pragma unroll
    for (int j = 8; j > 0; j >>= 1)
#pragma unroll
        for (int i = 0; i < 16; ++i) {
            const int l = i ^ j;
            if (l > i) { const int a = v[i], b = v[l]; v[i] = imax(a, b); v[l] = imin(a, b); }
        }
}
__device__ __forceinline__ void top16_of_64(int (&v)[64], int (&out)[16]) {
    bitonic_sort16<0>(v); bitonic_sort16<16>(v); bitonic_sort16<32>(v); bitonic_sort16<48>(v);
    int a[16], b[16];
#pragma unroll
    for (int i = 0; i < 16; ++i) { a[i] = imax(v[i], v[31 - i]); b[i] = imax(v[32 + i], v[63 - i]); }
    bitonic_merge16(a); bitonic_merge16(b);
#pragma unroll
    for (int i = 0; i < 16; ++i) out[i] = imax(a[i], b[15 - i]);
    bitonic_merge16(out);
}
__device__ __forceinline__ int sel4(int d0, int d1, int d2, int d3, int q) { const int lo = (q & 1) ? d1 : d0, hi = (q & 1) ? d3 : d2; return (q & 2) ? hi : lo; }


__device__ __forceinline__ void route_scores(const bf16* qpb, const bf16* keysb, int t0, int h, int p, int r, int hh, int (&M)[16]) {
    f32x16 acc[4];
#pragma unroll
    for (int nb = 0; nb < 4; ++nb)
#pragma unroll
        for (int i = 0; i < 16; ++i) acc[nb][i] = 0.f;
    const bf16* qrow = qpb + (size_t)(t0 + r) * NQ + h * PQ + p * 128 + 8 * hh;
    const bf16* krow = keysb + ((size_t)(h * 2 + p) * PN + r) * 128 + 8 * hh;
#pragma unroll 2
    for (int s = 0; s < 8; ++s) {
        const bf16x8 qf = *(const bf16x8*)(qrow + 16 * s);
#pragma unroll
        for (int nb = 0; nb < 4; ++nb) {
            const bf16x8 kf = *(const bf16x8*)(krow + (size_t)(32 * nb) * 128 + 16 * s);
            acc[nb] = __builtin_amdgcn_mfma_f32_32x32x16_bf16(kf, qf, acc[nb], 0, 0, 0);
        }
    }
    int v[64];
#pragma unroll
    for (int nb = 0; nb < 4; ++nb)
#pragma unroll
        for (int i = 0; i < 16; ++i) {
            const int n = 32 * nb + (i & 3) + 8 * (i >> 2) + 4 * hh;
            v[nb * 16 + i] = (f2ord(acc[nb][i]) & ~127) | n;
        }
    int L[16];
    top16_of_64(v, L);
#pragma unroll
    for (int i = 0; i < 16; ++i) M[i] = imax(L[i], __shfl_xor(L[15 - i], 32));
    bitonic_merge16(M);
}

__device__ __forceinline__ void phase_route(const Args& a, int lane, int wave) {
    const bf16* qpb = (const bf16*)(a.ws + WS_QPB); const bf16* keysb = (const bf16*)(a.ws + WS_KEYSB);
    int* eidx = (int*)(a.ws + WS_EIDX); float* egate = (float*)(a.ws + WS_EGATE);
    const int r = lane & 31, hh = lane >> 5;
    for (int task = blockIdx.x * NWAVES + wave; task < (T / 32) * PH; task += gridDim.x * NWAVES) {
        const int tb = task >> 3, h = task & 7, t0 = tb * 32;
        int listA[16], listB[16];
        route_scores(qpb, keysb, t0, h, 0, r, hh, listA);
        __builtin_amdgcn_sched_barrier(0);
        route_scores(qpb, keysb, t0, h, 1, r, hh, listB);
        __builtin_amdgcn_sched_barrier(0);
        float fa[16], fb[16];
#pragma unroll
        for (int i = 0; i < 16; ++i) { fa[i] = ord2f(listA[i] & ~127); fb[i] = ord2f(listB[i] & ~127); }
        int cv[64];
        {
            int c = 0;
#pragma unroll
            for (int i = 0; i < 16; ++i)
#pragma unroll
                for (int j = 0; j < 16; ++j)
                    if ((i + 1) * (j + 1) <= 16) { cv[c] = (f2ord(fa[i] + fb[j]) & ~255) | (i * 16 + j); ++c; }
#pragma unroll
            for (int q = 50; q < 64; ++q) cv[q] = (int)0x80000000;
        }
        int sel[16];
        top16_of_64(cv, sel);
        int ia[4], ib[4];
#pragma unroll
        for (int q = 0; q < 4; ++q) {
            ia[q] = (listA[4 * q] & 127) | ((listA[4 * q + 1] & 127) << 8) | ((listA[4 * q + 2] & 127) << 16) | ((listA[4 * q + 3] & 127) << 24);
            ib[q] = (listB[4 * q] & 127) | ((listB[4 * q + 1] & 127) << 8) | ((listB[4 * q + 2] & 127) << 16) | ((listB[4 * q + 3] & 127) << 24);
        }
        float val[16]; int ex[16];
        float mx = -3.0e38f;
#pragma unroll
        for (int k = 0; k < 16; ++k) {
            const int pos = sel[k] & 255, i = pos >> 4, j = pos & 15;
            val[k] = ord2f(sel[k] & ~255);
            mx = fmaxf(mx, val[k]);
            const int na = (sel4(ia[0], ia[1], ia[2], ia[3], i >> 2) >> ((i & 3) * 8)) & 127;
            const int nb_ = (sel4(ib[0], ib[1], ib[2], ib[3], j >> 2) >> ((j & 3) * 8)) & 127;
            ex[k] = na * PN + nb_;
        }
        float sum = 0.f;
#pragma unroll
        for (int k = 0; k < 16; ++k) { val[k] = __expf(val[k] - mx); sum += val[k]; }
        const float inv = 1.f / sum;
        if (hh == 0) {
            const size_t ob = ((size_t)(t0 + r) * PH + h) * PK;
#pragma unroll
            for (int q = 0; q < 4; ++q) {
                *(v4u*)(eidx + ob + 4 * q) = (v4u){(unsigned)ex[4 * q], (unsigned)ex[4 * q + 1], (unsigned)ex[4 * q + 2], (unsigned)ex[4 * q + 3]};
                *(f32x4*)(egate + ob + 4 * q) = (f32x4){val[4 * q] * inv, val[4 * q + 1] * inv, val[4 * q + 2] * inv, val[4 * q + 3] * inv};
            }
        }
    }
}


typedef float f32x2v __attribute__((ext_vector_type(2)));
__device__ __forceinline__ float wave_max(float v) {
#pragma unroll
    for (int o = 1; o < 64; o <<= 1) v = fmaxf(v, __shfl_xor(v, o));
    return v;
}
__device__ __forceinline__ void p0_tables(const Args& a, LAS unsigned char* lds, int lane, int wave, int first_block, int nblocks, int grp_lo, int grp_hi) {
    LAS unsigned* stage = (LAS unsigned*)lds;
    int grp = grp_lo + (int)blockIdx.x - first_block;
    if (grp >= grp_hi) return;
    f32x4 v[16];
    {   const int row = grp * 8 + wave, up = row >= NE, e = up ? row - NE : row;
        const float* src = (up ? a.in[13] : a.in[12]) + (size_t)e * D;
#pragma unroll
        for (int j = 0; j < 16; ++j) v[j] = __builtin_nontemporal_load((const f32x4*)(src + 4 * (lane + 64 * j))); }
    for (; grp < grp_hi; grp += nblocks) {
        const int row = grp * 8 + wave, up = row >= NE, e = up ? row - NE : row;
        float* scl = (float*)(a.ws + (up ? WS_SU : WS_SD));
        float m = 0.f;
#pragma unroll
        for (int j = 0; j < 16; ++j) m = fmaxf(fmaxf(m, fmaxf(fabsf(v[j][0]), fabsf(v[j][1]))), fmaxf(fabsf(v[j][2]), fabsf(v[j][3])));
        m = wave_max(m);
        const float inv = m > 0.f ? 440.f / m : 0.f;
#pragma unroll
        for (int j = 0; j < 16; ++j) {
            int p = 0;
            p = __builtin_amdgcn_cvt_pk_fp8_f32(v[j][0] * inv, v[j][1] * inv, p, false);
            p = __builtin_amdgcn_cvt_pk_fp8_f32(v[j][2] * inv, v[j][3] * inv, p, true);
            stage[wave * 1024 + lane + 64 * j] = (unsigned)p;
        }
        if (lane == 0) scl[e] = m * (1.f / 440.f);
        if (grp + nblocks < grp_hi) {
            const int rown = (grp + nblocks) * 8 + wave, upn = rown >= NE, en = upn ? rown - NE : rown;
            const float* src = (upn ? a.in[13] : a.in[12]) + (size_t)en * D;
#pragma unroll
            for (int j = 0; j < 16; ++j) v[j] = __builtin_nontemporal_load((const f32x4*)(src + 4 * (lane + 64 * j)));
        }
        LDS_WAIT(); __builtin_amdgcn_s_barrier();
        {
            const int e0 = (grp * 8) % NE, r8 = lane >> 3, pc = lane & 7;
            unsigned char* dstb = a.ws + ((grp * 8 >= NE) ? WS_WU8 : WS_WD8);
#pragma unroll
            for (int q = 0; q < 4; ++q) {
                const int ds = wave * 4 + q;
                const v4u t = *(const LAS v4u*)(stage + r8 * 1024 + ds * 32 + pc * 4);
                __builtin_nontemporal_store(t, (v4u*)(dstb + (size_t)ds * (NE * 128) + (size_t)(e0 + r8) * 128 + pc * 16));
            }
        }
        LDS_WAIT(); __builtin_amdgcn_s_barrier();
    }
}

__device__ __forceinline__ float dot16_fp8(const v4u w, const f32x4 (&x)[4], float p) {
#pragma unroll
    for (int q = 0; q < 4; ++q) {
        const f32x2v lo = __builtin_amdgcn_cvt_pk_f32_fp8((int)w[q], false), hi = __builtin_amdgcn_cvt_pk_f32_fp8((int)w[q], true);
        p = fmaf(lo[0], x[q][0], p); p = fmaf(lo[1], x[q][1], p); p = fmaf(hi[0], x[q][2], p); p = fmaf(hi[1], x[q][3], p);
    }
    return p;
}


typedef int i32x4v __attribute__((ext_vector_type(4)));
typedef _Float16 h2v __attribute__((ext_vector_type(2)));
#define BF8_H(w, sel) __builtin_bit_cast(h2v, __builtin_amdgcn_perm((unsigned)(w), 0u, (sel)))
#define FP8_H(w, hi) __builtin_bit_cast(h2v, __builtin_amdgcn_cvt_scalef32_pk_f16_fp8((int)(w), 0.00390625f, (hi)))
__device__ __forceinline__ v4u tbl_load(__amdgpu_buffer_rsrc_t rs, unsigned voff, unsigned soff) {
    return __builtin_bit_cast(v4u, __builtin_amdgcn_raw_buffer_load_b128(rs, (int)voff, (int)soff, 0)); }

template <int PROBE>
__device__ __forceinline__ void phase_expert_down(const Args& a, int lane, int wave) {
    unsigned char* ws = a.ws;
    const float* sd = (const float*)(ws + WS_SD); const float* su = (const float*)(ws + WS_SU);
    const int* eidx = (const int*)(ws + WS_EIDX); const float* egate = (const float*)(ws + WS_EGATE);
    const bf16* x1b = (const bf16*)(ws + WS_X1B); float* abuf = (float*)(ws + (PROBE ? WS_XB : WS_ABUF));
    const __amdgpu_buffer_rsrc_t rs = __builtin_amdgcn_make_buffer_rsrc((void*)(ws + WS_WD8), 0, NE * D, 0x00020000);
    const int r8 = lane >> 3, pc = lane & 7;
    if (wave >= 4) __builtin_amdgcn_s_sleep(50);
    for (int tb = blockIdx.x * NWAVES + wave; tb < T / 4; tb += gridDim.x * NWAVES) {
        const int t0 = tb * 4;
        unsigned epk[4][8];
#pragma unroll
        for (int q = 0; q < 4; ++q)
#pragma unroll
            for (int k = 0; k < 8; ++k) epk[q][k] = (unsigned)eidx[(size_t)(t0 + q) * 128 + 8 * (2 * k) + r8] | ((unsigned)eidx[(size_t)(t0 + q) * 128 + 8 * (2 * k + 1) + r8] << 16);
        const unsigned pco = (unsigned)pc * 16u;
        float acc[4][16];
#pragma unroll
        for (int q = 0; q < 4; ++q)
#pragma unroll
            for (int k = 0; k < 16; ++k) acc[q][k] = 0.f;
        for (int ds = 0; ds < 32; ++ds) {
            const unsigned soff = (unsigned)ds * (unsigned)(NE * 128);
#pragma unroll
            for (int q = 0; q < 4; ++q) {
#pragma unroll
                for (int k = 0; k < 8; ++k) asm volatile("" : "+v"(epk[q][k]));
                const bf16* xp = x1b + (size_t)(t0 + q) * D + ds * 128 + pc * 16;
                const v4u xa = *(const v4u*)xp, xb = *(const v4u*)(xp + 8);
                v4u w[16];
#pragma unroll
                for (int k = 0; k < 16; ++k) { unsigned eo = ((((k & 1) ? (epk[q][k >> 1] >> 16) : (epk[q][k >> 1] & 0xffffu)) << 7) + pco);
                    if (PROBE == 1) eo &= 0xffffu;
                    w[k] = tbl_load(rs, eo, soff); }
                h2v xs[8];
#pragma unroll
                for (int i = 0; i < 4; ++i) { xs[i] = __builtin_convertvector((f32x2v){bflo(xa[i]), bfhi(xa[i])}, h2v); xs[4 + i] = __builtin_convertvector((f32x2v){bflo(xb[i]), bfhi(xb[i])}, h2v); }
#pragma unroll
                for (int k = 0; k < 16; ++k) {
                    if (PROBE == 2) { acc[q][k] += __builtin_bit_cast(float, (w[k][0] ^ w[k][1] ^ w[k][2] ^ w[k][3]) & 0x3fffffffu) * (float)xs[0][0]; continue; }
                    h2v t = (h2v){(_Float16)0.f, (_Float16)0.f};
#pragma unroll
                    for (int d = 0; d < 4; ++d) { t = __builtin_elementwise_fma(FP8_H(w[k][d], false), xs[2 * d], t); t = __builtin_elementwise_fma(FP8_H(w[k][d], true), xs[2 * d + 1], t); }
                    acc[q][k] += (float)t[0] + (float)t[1];
                }
            }
        }
#pragma unroll
        for (int q = 0; q < 4; ++q)
#pragma unroll
            for (int k0 = 0; k0 < 16; k0 += 8) {
                float r4[4], r2[2];
#pragma unroll
                for (int k = 0; k < 4; ++k) { const bool o = lane & 1; const float keep = o ? acc[q][k0 + 2 * k + 1] : acc[q][k0 + 2 * k], send = o ? acc[q][k0 + 2 * k] : acc[q][k0 + 2 * k + 1]; r4[k] = keep + __shfl_xor(send, 1); }
#pragma unroll
                for (int k = 0; k < 2; ++k) { const bool o = lane & 2; const float keep = o ? r4[2 * k + 1] : r4[2 * k], send = o ? r4[2 * k] : r4[2 * k + 1]; r2[k] = keep + __shfl_xor(send, 2); }
                const bool o = lane & 4; const float keep = o ? r2[1] : r2[0], send = o ? r2[0] : r2[1];
                const float z = keep + __shfl_xor(send, 4);
                const size_t pi = (size_t)(t0 + q) * 128 + 8 * (k0 + pc) + r8;
                const int e = eidx[pi];
                abuf[pi] = gelu_f(z * (256.f * sd[e])) * egate[pi] * (256.f * su[e]);
            }
    }
}

template <int PROBE>
__device__ __forceinline__ void phase_expert_up(const Args& a, LAS unsigned char* lds, int lane, int wave) {
    unsigned char* ws = a.ws;
    const int* eidx = (const int*)(ws + WS_EIDX);
    const bf16* x1b = (const bf16*)(ws + WS_X1B); const float* abuf = (const float*)(ws + WS_ABUF); float* out = a.out;
    bf16* vb16 = (bf16*)(ws + WS_PRE1);
    const float* g2 = a.in[14]; const float* b2 = a.in[15];
    const __amdgpu_buffer_rsrc_t rs = __builtin_amdgcn_make_buffer_rsrc((void*)(ws + WS_WU8), 0, NE * D, 0x00020000);
    const int r8 = lane >> 3, pc = lane & 7;
    if (wave >= 4) __builtin_amdgcn_s_sleep(50);
    LAS unsigned* lw = (LAS unsigned*)(lds + wave * 16384) + lane;
    for (int tb = blockIdx.x * NWAVES + wave; tb < T / 4; tb += gridDim.x * NWAVES) {
        const int t0 = tb * 4;
#pragma unroll
        for (int q = 0; q < 4; ++q) {
#pragma unroll
            for (int k = 0; k < 8; ++k) {
                lw[(q * 16 + k) * 64] = (unsigned)eidx[(size_t)(t0 + q) * 128 + 8 * (2 * k) + r8] | ((unsigned)eidx[(size_t)(t0 + q) * 128 + 8 * (2 * k + 1) + r8] << 16);
                lw[(q * 16 + 8 + k) * 64] = __builtin_bit_cast(unsigned, __builtin_convertvector((f32x2v){abuf[(size_t)(t0 + q) * 128 + 8 * (2 * k) + r8], abuf[(size_t)(t0 + q) * 128 + 8 * (2 * k + 1) + r8]}, h2v));
            }
        }
        LDS_WAIT();
        const unsigned pco = (unsigned)pc * 16u;
        float s1[4], s2[4];
#pragma unroll
        for (int q = 0; q < 4; ++q) { s1[q] = 0.f; s2[q] = 0.f; }
#define UP_OFF(ek, k) ((((((k) & 1) ? (ek[((k) & 7) >> 1] >> 16) : (ek[((k) & 7) >> 1] & 0xffffu)) << 7) + pco) & (PROBE ? 0xffffu : 0xffffffffu))
#define UP_EK(dst, q, kh) _Pragma("unroll") for (int j = 0; j < 4; ++j) dst[j] = lw[((q) * 16 + (kh) / 2 + j) * 64];
#define UP_LD(dst, ek, so) _Pragma("unroll") for (int k = 0; k < 8; ++k) dst[k] = tbl_load(rs, UP_OFF(ek, k), so);
#define UP_MM(src, q, kh) { unsigned ak[4]; _Pragma("unroll") for (int j = 0; j < 4; ++j) ak[j] = lw[((q) * 16 + 8 + (kh) / 2 + j) * 64]; \
        _Pragma("unroll") for (int k = 0; k < 8; ++k) { \
            const h2v ap = __builtin_bit_cast(h2v, ak[k >> 1]); const h2v s2v = (k & 1) ? (h2v){ap[1], ap[1]} : (h2v){ap[0], ap[0]}; \
            _Pragma("unroll") for (int d = 0; d < 4; ++d) { \
                y[2 * d] = __builtin_elementwise_fma(FP8_H(src[k][d], false), s2v, y[2 * d]); y[2 * d + 1] = __builtin_elementwise_fma(FP8_H(src[k][d], true), s2v, y[2 * d + 1]); } } }
#define SBR() __builtin_amdgcn_sched_barrier(0)
        v4u wa[8], wb[8];
        unsigned eka[4], ekb[4];
        { UP_EK(eka, 0, 0); UP_LD(wa, eka, 0u); UP_EK(ekb, 0, 8); }
        for (int ds = 0; ds < 32; ++ds) {
            const unsigned soff = (unsigned)ds * (unsigned)(NE * 128);
            const unsigned soffn = (unsigned)(ds + 1 < 32 ? ds + 1 : ds) * (unsigned)(NE * 128);
#pragma unroll
            for (int q = 0; q < 4; ++q) {
                h2v y[8];
#pragma unroll
                for (int i = 0; i < 8; ++i) y[i] = (h2v){(_Float16)0.f, (_Float16)0.f};
                const size_t oi = (size_t)(t0 + q) * D + ds * 128 + pc * 16 + 2 * r8;
                const unsigned xw = *(const unsigned*)(x1b + oi);
                UP_LD(wb, ekb, soff);
                if (q < 3) { UP_EK(eka, q + 1, 0); } else { UP_EK(eka, 0, 0); }
                SBR(); UP_MM(wa, q, 0); SBR();
                if (q < 3) { UP_LD(wa, eka, soff); UP_EK(ekb, q + 1, 8); } else { UP_LD(wa, eka, soffn); UP_EK(ekb, 0, 8); }
                SBR(); UP_MM(wb, q, 8); SBR();
                h2v y4[4], y2[2];
#pragma unroll
                for (int i = 0; i < 4; ++i) { const bool o = lane & 32; const h2v keep = o ? y[4 + i] : y[i], send = o ? y[i] : y[4 + i];
                    y4[i] = keep + __builtin_bit_cast(h2v, __shfl_xor(__builtin_bit_cast(int, send), 32)); }
#pragma unroll
                for (int i = 0; i < 2; ++i) { const bool o = lane & 16; const h2v keep = o ? y4[2 + i] : y4[i], send = o ? y4[i] : y4[2 + i];
                    y2[i] = keep + __builtin_bit_cast(h2v, __shfl_xor(__builtin_bit_cast(int, send), 16)); }
                f32x2v yv; { const bool o = lane & 8; const h2v keep = o ? y2[1] : y2[0], send = o ? y2[0] : y2[1];
                    const h2v yh = keep + __builtin_bit_cast(h2v, __shfl_xor(__builtin_bit_cast(int, send), 8)); yv = (f32x2v){(float)yh[0], (float)yh[1]}; }
                f32x2v v = (f32x2v){bflo(xw), bfhi(xw)} * ALPHA + yv;
                const unsigned vw = pkbf(v[0], v[1]);
                v = (f32x2v){bflo(vw), bfhi(vw)};
                s1[q] += v[0] + v[1]; s2[q] = fmaf(v[0], v[0], fmaf(v[1], v[1], s2[q]));
                *(unsigned*)(vb16 + oi) = vw;
            }
        }
#undef UP_OFF
#undef UP_EK
#undef UP_LD
#undef UP_MM
#undef SBR
#pragma unroll
        for (int q = 0; q < 4; ++q) {
            const float mean = wave_sum(s1[q]) * (1.f / D);
            const float var = wave_sum(s2[q]) * (1.f / D) - mean * mean;
            const float rstd = rsqrtf(fmaxf(var, 0.f) + LN_EPS);
            float* orow = out + (size_t)(t0 + q) * D; const bf16* vrow = vb16 + (size_t)(t0 + q) * D;
#pragma unroll
            for (int j = 0; j < 8; ++j) { const int c = 8 * (lane + 64 * j);
                const v4u vv = __builtin_nontemporal_load((const v4u*)(vrow + c));
                const f32x4 g0 = *(const f32x4*)(g2 + c), g1 = *(const f32x4*)(g2 + c + 4), b0 = *(const f32x4*)(b2 + c), b1 = *(const f32x4*)(b2 + c + 4);
                const f32x4 v0 = (f32x4){bflo(vv.x), bfhi(vv.x), bflo(vv.y), bfhi(vv.y)}, v1 = (f32x4){bflo(vv.z), bfhi(vv.z), bflo(vv.w), bfhi(vv.w)};
                __builtin_nontemporal_store((v0 - mean) * rstd * g0 + b0, (f32x4*)(orow + c)); __builtin_nontemporal_store((v1 - mean) * rstd * g1 + b1, (f32x4*)(orow + c + 4)); }
        }
    }
}


constexpr size_t GU_FR = 16 * 64 * 8 * 2;
constexpr size_t WS_G_KA = WS_PRE1;
constexpr size_t WS_G_QA = WS_G_KA + (size_t)2048 * GU_FR;
constexpr size_t WS_G_VB = WS_G_QA + (size_t)2048 * GU_FR;
constexpr size_t WS_G_KBT = WS_G_VB + (size_t)2048 * GU_FR;
constexpr size_t WS_G_KDT = WS_G_KBT + (size_t)2048 * GU_FR;
constexpr size_t WS_G_WN = WS_G_KDT + (size_t)2048 * GU_FR;
constexpr size_t WS_G_QKM = WS_G_WN + (size_t)2048 * GU_FR;
constexpr size_t WS_G_UU = WS_G_QKM + (size_t)2048 * 6 * 1024;
constexpr size_t WS_G_GC = WS_G_UU + (size_t)2048 * 32768;
constexpr size_t WS_G_BT = WS_G_GC + (size_t)2048 * 256;
constexpr size_t WS_G_END = WS_G_BT + (size_t)2048 * 256;
static_assert(WS_G_END <= WS_KEYSB, "GDN scratch must fit in the PRE1..QPB region (all written after the GDN is done)");

__device__ __forceinline__ bf16x8 ldfrag(const bf16* base, int frag, int lane) { return *(const bf16x8*)(base + ((size_t)frag * 64 + lane) * 8); }
__device__ __forceinline__ void stfrag(bf16* base, int frag, int lane, v4u v) { *(v4u*)(base + ((size_t)frag * 64 + lane) * 8) = v; }
__device__ __forceinline__ v4u pack8(float a0, float a1, float a2, float a3, float a4, float a5, float a6, float a7) {
    v4u o; o.x = pkbf(a0, a1); o.y = pkbf(a2, a3); o.z = pkbf(a4, a5); o.w = pkbf(a6, a7); return o; }
__device__ __forceinline__ bf16x8 packacc(const f32x16& x, int s) {
    return __builtin_bit_cast(bf16x8, pack8(x[8 * s], x[8 * s + 1], x[8 * s + 2], x[8 * s + 3], x[8 * s + 4], x[8 * s + 5], x[8 * s + 6], x[8 * s + 7])); }
#define MFMA32(a, b, c) __builtin_amdgcn_mfma_f32_32x32x16_bf16((a), (b), (c), 0, 0, 0)

constexpr int P2_LD = 129;
__device__ __forceinline__ void prep_load_rows(const bf16* projb, int tbase, int c, int h, int tid, v4u (&R)[11]) {
    const int ten = tid >> 7, rem = tid & 127, tg = rem >> 4, cc = rem & 15, col = ten * GW + h * GD + cc * 8;
#pragma unroll
    for (int i = 0; i < 11; ++i) {
        const int tok = tg * 8 - 3 + i;
        if (c * 64 + tok >= 0) R[i] = *(const v4u*)(projb + (size_t)(tbase + tok) * NP + col);
        else R[i] = (v4u){0u, 0u, 0u, 0u};
    }
}
__device__ __forceinline__ void phase_gdn_prep(const Args& a, LAS unsigned char* lds, int tid, int lane, int wave) {
    unsigned char* ws = a.ws;
    const bf16* projb = (const bf16*)(ws + WS_PROJ); const float* braw = (const float*)(ws + WS_BRAW);
    const float* conv_qkv = a.in[2]; const float* a_log = a.in[3]; const float* dt_bias = a.in[4];
    LAS float* xs = (LAS float*)lds;
    LAS float* ssq = xs + 3 * 64 * P2_LD;
    LAS float* gcs = ssq + 256;
    LAS float* bts = gcs + 64;
    LAS float* cw = bts + 64;
    for (int grp = blockIdx.x; grp < 256; grp += gridDim.x) {
        const int bh = grp >> 2, c0 = (grp & 3) * 8, b = bh >> 4, h = bh & 15;
        for (int e = tid; e < 4 * 384; e += NTHREADS) { const int j = e / 384, cl = e % 384; cw[e] = conv_qkv[j * 3 * GW + (cl >> 7) * GW + h * GD + (cl & 127)]; }
        if (tid < 256) ssq[tid] = 0.f;
        v4u R[11], Rn[11];
        float braw_b = 0.f, braw_a = 0.f;
        if (tid < 384) prep_load_rows(projb, b * S + c0 * 64, c0, h, tid, R);
        if (wave == 7) { const int t = b * S + c0 * 64 + lane; braw_b = braw[(size_t)t * 32 + h]; braw_a = braw[(size_t)t * 32 + 16 + h]; }
        __syncthreads();
        for (int ci = 0; ci < 8; ++ci) {
            const int c = c0 + ci, u = bh * 32 + c, sb = ci & 1;
            LAS float* sq = ssq + sb * 128;
            if (ci + 1 < 8 && tid < 384) prep_load_rows(projb, b * S + (c + 1) * 64, c + 1, h, tid, Rn);
            if (tid < 384) {
                const int ten = tid >> 7, rem = tid & 127, tg = rem >> 4, cc = rem & 15;
                float wv[4][8];
#pragma unroll
                for (int j = 0; j < 4; ++j)
#pragma unroll
                    for (int e = 0; e < 8; ++e) wv[j][e] = cw[j * 384 + ten * 128 + cc * 8 + e];
#pragma unroll
                for (int i = 0; i < 8; ++i) {
                    float acc[8];
#pragma unroll
                    for (int e = 0; e < 8; ++e) acc[e] = 0.f;
#pragma unroll
                    for (int j = 0; j < 4; ++j) { const v4u w = R[i + j];
                        acc[0] = fmaf(wv[j][0], bflo(w.x), acc[0]); acc[1] = fmaf(wv[j][1], bfhi(w.x), acc[1]); acc[2] = fmaf(wv[j][2], bflo(w.y), acc[2]); acc[3] = fmaf(wv[j][3], bfhi(w.y), acc[3]);
                        acc[4] = fmaf(wv[j][4], bflo(w.z), acc[4]); acc[5] = fmaf(wv[j][5], bfhi(w.z), acc[5]); acc[6] = fmaf(wv[j][6], bflo(w.w), acc[6]); acc[7] = fmaf(wv[j][7], bfhi(w.w), acc[7]); }
                    float s2 = 0.f; const int tok = tg * 8 + i;
#pragma unroll
                    for (int e = 0; e < 8; ++e) { acc[e] = silu_f(acc[e]); s2 = fmaf(acc[e], acc[e], s2); xs[(ten * 64 + tok) * P2_LD + cc * 8 + e] = acc[e]; }
                    if (ten < 2) atomicAdd((float*)(sq + ten * 64 + tok), s2);
                }
            }
            if (wave == 7) {
                const float be = sigmoid_f(braw_b);
                float g = -expf(a_log[h]) * softplus_f(braw_a + dt_bias[h]);
#pragma unroll
                for (int o = 1; o < 64; o <<= 1) { const float n = __shfl_up(g, o); if (lane >= o) g += n; }
                gcs[lane] = g; bts[lane] = be;
                ((float*)(ws + WS_G_GC))[(size_t)u * 64 + lane] = g; ((float*)(ws + WS_G_BT))[(size_t)u * 64 + lane] = be;
            }
            LDS_WAIT(); __builtin_amdgcn_s_barrier();
            if (ci + 1 < 8) {
                if (tid < 384) {
#pragma unroll
                    for (int i = 0; i < 11; ++i) R[i] = Rn[i];
                }
                if (wave == 7) { const int t = b * S + (c + 1) * 64 + lane; braw_b = braw[(size_t)t * 32 + h]; braw_a = braw[(size_t)t * 32 + 16 + h]; }
            }
            if (tid < 128) ssq[(sb ^ 1) * 128 + tid] = 0.f;
            const float glast = gcs[63];
#pragma unroll
            for (int i = 0; i < 10; ++i) {
                const int f = tid + 512 * i, buf = f >> 10, fr = (f >> 6) & 15, l = f & 63, r = l & 31, hh = l >> 5;
                float o[8];
                if (buf < 2) {
                    const int I = fr >> 3, s = fr & 7, ten = buf == 0 ? 1 : 0, row = 32 * I + r;
                    const float sc = rsqrtf(sq[ten * 64 + row] + RMS_EPS) * (buf == 0 ? 1.f : 0.08838834764831845f);
#pragma unroll
                    for (int j = 0; j < 8; ++j) o[j] = xs[(ten * 64 + row) * P2_LD + 16 * s + 8 * (j >> 2) + 4 * hh + (j & 3)] * sc;
                } else if (buf == 2) {
                    const int s = fr >> 2, cb = fr & 3;
#pragma unroll
                    for (int j = 0; j < 8; ++j) { const int tok = 16 * s + 8 * hh + j; o[j] = xs[(2 * 64 + tok) * P2_LD + 32 * cb + r] * bts[tok]; }
                } else if (buf == 3) {
                    const int cb = fr >> 2, s = fr & 3;
#pragma unroll
                    for (int j = 0; j < 8; ++j) { const int tok = 16 * s + 8 * hh + j;
                        o[j] = xs[(1 * 64 + tok) * P2_LD + 32 * cb + r] * (rsqrtf(sq[64 + tok] + RMS_EPS) * bts[tok] * __expf(gcs[tok])); }
                } else {
                    const int cp = fr >> 2, J = (fr >> 1) & 1, sp = fr & 1;
#pragma unroll
                    for (int j = 0; j < 8; ++j) { const int tok = 32 * J + 16 * sp + 8 * (j >> 2) + 4 * hh + (j & 3);
                        o[j] = xs[(1 * 64 + tok) * P2_LD + 32 * cp + r] * (rsqrtf(sq[64 + tok] + RMS_EPS) * __expf(glast - gcs[tok])); }
                }
                bf16* dst = (bf16*)(ws + (buf == 0 ? WS_G_KA : buf == 1 ? WS_G_QA : buf == 2 ? WS_G_VB : buf == 3 ? WS_G_KBT : WS_G_KDT)) + (size_t)u * (GU_FR / 2);
                stfrag(dst, fr, l, pack8(o[0], o[1], o[2], o[3], o[4], o[5], o[6], o[7]));
            }
            LDS_WAIT(); __builtin_amdgcn_s_barrier();
        }
    }
    {
        const float* conv_short = a.in[6]; unsigned char* cat8 = ws + WS_CAT;
        for (int item = blockIdx.x * NTHREADS + tid; item < (T / 16) * (GW / 8); item += gridDim.x * NTHREADS) {
            const int run = item >> 8, cc = item & 255, col = cc * 8, tfirst = run * 16;
            float cw3[3][8];
#pragma unroll
            for (int jt = 0; jt < 3; ++jt) { const f32x4 c0 = *(const f32x4*)(conv_short + jt * GW + col), c1 = *(const f32x4*)(conv_short + jt * GW + col + 4);
#pragma unroll
                for (int e = 0; e < 4; ++e) { cw3[jt][e] = c0[e]; cw3[jt][4 + e] = c1[e]; } }
            float p1[8], p2[8];
#pragma unroll
            for (int e = 0; e < 8; ++e) { p1[e] = 0.f; p2[e] = 0.f; }
            if ((tfirst & (S - 1)) != 0) {
                const size_t r1 = (size_t)(tfirst - 1) * NP, r2 = (size_t)(tfirst - 2) * NP;
                const v4u g1 = *(const v4u*)(projb + r1 + PGC0 + col), h1 = *(const v4u*)(projb + r1 + PH0 + col), g2 = *(const v4u*)(projb + r2 + PGC0 + col), h2 = *(const v4u*)(projb + r2 + PH0 + col);
#pragma unroll
                for (int e = 0; e < 4; ++e) { p1[2 * e] = bflo(g1[e]) * bflo(h1[e]); p1[2 * e + 1] = bfhi(g1[e]) * bfhi(h1[e]); p2[2 * e] = bflo(g2[e]) * bflo(h2[e]); p2[2 * e + 1] = bfhi(g2[e]) * bfhi(h2[e]); }
            }
#pragma unroll 4
            for (int i = 0; i < 16; ++i) {
                const size_t row = (size_t)(tfirst + i) * NP;
                const v4u gc = *(const v4u*)(projb + row + PGC0 + col), hv = *(const v4u*)(projb + row + PH0 + col), gb = *(const v4u*)(projb + row + PGB0 + col);
                float p0[8], y[8];
#pragma unroll
                for (int e = 0; e < 4; ++e) { p0[2 * e] = bflo(gc[e]) * bflo(hv[e]); p0[2 * e + 1] = bfhi(gc[e]) * bfhi(hv[e]); }
#pragma unroll
                for (int e = 0; e < 8; ++e) y[e] = fmaf(cw3[2][e], p0[e], fmaf(cw3[1][e], p1[e], cw3[0][e] * p2[e]));
                const unsigned long long o8 = (unsigned long long)pk4_fp8(y[0] * bflo(gb.x), y[1] * bfhi(gb.x), y[2] * bflo(gb.y), y[3] * bfhi(gb.y)) |
                                              ((unsigned long long)pk4_fp8(y[4] * bflo(gb.z), y[5] * bfhi(gb.z), y[6] * bflo(gb.w), y[7] * bfhi(gb.w)) << 32);
                *(unsigned long long*)(cat8 + (size_t)(tfirst + i) * D + GW + col) = o8;
#pragma unroll
                for (int e = 0; e < 8; ++e) { p2[e] = p1[e]; p1[e] = p0[e]; }
            }
        }
    }
    rescale_rows_fp8(ws + WS_WOUT8, (const signed char*)(ws + WS_ETAB_OUT), (float*)(ws + WS_SWOUT), (const unsigned*)(ws + WS_CTL + CTL_WOMAX), D, 1.f, lane, wave);
}

template <int J, int Q>
struct SubstInner {
    static __device__ __forceinline__ void run(const float (&Tr)[64], const LAS float* Mt, float& a0, float& a1) {
        if constexpr (Q < 16) {
            const f32x4 mq = *(const LAS f32x4*)(Mt + J * 64 + 4 * Q);
            if constexpr (4 * Q + 0 > J) a0 = fmaf(Tr[4 * Q + 0], mq[0], a0);
            if constexpr (4 * Q + 1 > J) a1 = fmaf(Tr[4 * Q + 1], mq[1], a1);
            if constexpr (4 * Q + 2 > J) a0 = fmaf(Tr[4 * Q + 2], mq[2], a0);
            if constexpr (4 * Q + 3 > J) a1 = fmaf(Tr[4 * Q + 3], mq[3], a1);
            SubstInner<J, Q + 1>::run(Tr, Mt, a0, a1);
        }
    }
};
template <int J>
struct SubstOuter {
    static __device__ __forceinline__ void run(float (&Tr)[64], const LAS float* Mt, int lane) {
        float a0 = 0.f, a1 = 0.f;
        SubstInner<J, (J + 1) / 4>::run(Tr, Mt, a0, a1);
        asm volatile("" : "+v"(lane));
        Tr[J] = (lane == J ? 1.f : 0.f) - (a0 + a1);
        asm volatile("" : "+v"(Mt), "+v"(Tr[J]));
        if constexpr (J > 0) SubstOuter<J - 1>::run(Tr, Mt, lane);
    }
};

__device__ __forceinline__ void phase_gdn_solve(const Args& a, LAS unsigned char* lds, int lane, int wave) {
    unsigned char* ws = a.ws;
    const int r = lane & 31, hh = lane >> 5;
    LAS float* Mt = (LAS float*)(lds + wave * 16384);
    for (int u = blockIdx.x * NWAVES + wave; u < 2048; u += gridDim.x * NWAVES) {
        const bf16* KA = (const bf16*)(ws + WS_G_KA) + (size_t)u * (GU_FR / 2); const bf16* QA = (const bf16*)(ws + WS_G_QA) + (size_t)u * (GU_FR / 2);
        const bf16* VB = (const bf16*)(ws + WS_G_VB) + (size_t)u * (GU_FR / 2); const bf16* KBT = (const bf16*)(ws + WS_G_KBT) + (size_t)u * (GU_FR / 2);
        bf16* WN = (bf16*)(ws + WS_G_WN) + (size_t)u * (GU_FR / 2); bf16* QKM = (bf16*)(ws + WS_G_QKM) + (size_t)u * (6 * 512);
        v4u* UU = (v4u*)(ws + WS_G_UU) + (size_t)u * 1024;
        const float* GC = (const float*)(ws + WS_G_GC) + (size_t)u * 64; const float* BT = (const float*)(ws + WS_G_BT) + (size_t)u * 64;
        const float gi0 = GC[r], gi1 = GC[32 + r], bi0 = BT[r], bi1 = BT[32 + r];
        f32x4 gm[2][4];
#pragma unroll
        for (int J = 0; J < 2; ++J)
#pragma unroll
            for (int g = 0; g < 4; ++g) gm[J][g] = *(const f32x4*)(GC + 32 * J + 8 * g + 4 * hh);
        {
            f32x16 q00, q10, q11;
#pragma unroll
            for (int i = 0; i < 16; ++i) { q00[i] = 0.f; q10[i] = 0.f; q11[i] = 0.f; }
#pragma unroll 2
            for (int s = 0; s < 8; ++s) {
                const bf16x8 k0 = ldfrag(KA, s, lane), k1 = ldfrag(KA, 8 + s, lane), qq0 = ldfrag(QA, s, lane), qq1 = ldfrag(QA, 8 + s, lane);
                q00 = MFMA32(k0, qq0, q00); q10 = MFMA32(k0, qq1, q10); q11 = MFMA32(k1, qq1, q11);
            }
#pragma unroll
            for (int i = 0; i < 16; ++i) {
                const int g = i >> 2, e = i & 3, mloc = e + 8 * g + 4 * hh;
                const float gj0 = gm[0][g][e], gj1 = gm[1][g][e];
                q00[i] = (mloc <= r) ? q00[i] * __expf(gi0 - gj0) : 0.f;
                q10[i] = q10[i] * __expf(gi1 - gj0);
                q11[i] = (mloc <= r) ? q11[i] * __expf(gi1 - gj1) : 0.f;
            }
            stfrag(QKM, 0, lane, __builtin_bit_cast(v4u, packacc(q00, 0))); stfrag(QKM, 1, lane, __builtin_bit_cast(v4u, packacc(q00, 1)));
            stfrag(QKM, 2, lane, __builtin_bit_cast(v4u, packacc(q10, 0))); stfrag(QKM, 3, lane, __builtin_bit_cast(v4u, packacc(q10, 1)));
            stfrag(QKM, 4, lane, __builtin_bit_cast(v4u, packacc(q11, 0))); stfrag(QKM, 5, lane, __builtin_bit_cast(v4u, packacc(q11, 1)));
        }
        __builtin_amdgcn_sched_barrier(0);
        f32x16 m00, m10, m11;
#pragma unroll
        for (int i = 0; i < 16; ++i) { m00[i] = 0.f; m10[i] = 0.f; m11[i] = 0.f; }
#pragma unroll 4
        for (int s = 0; s < 8; ++s) {
            const bf16x8 k0 = ldfrag(KA, s, lane), k1 = ldfrag(KA, 8 + s, lane);
            m00 = MFMA32(k0, k0, m00); m10 = MFMA32(k0, k1, m10); m11 = MFMA32(k1, k1, m11);
        }
#pragma unroll
        for (int i = 0; i < 16; ++i) {
            const int g = i >> 2, e = i & 3, mloc = e + 8 * g + 4 * hh;
            const float gj0 = gm[0][g][e], gj1 = gm[1][g][e];
            m00[i] = (mloc < r) ? bi0 * m00[i] * __expf(gi0 - gj0) : 0.f;
            m10[i] = bi1 * m10[i] * __expf(gi1 - gj0);
            m11[i] = (mloc < r) ? bi1 * m11[i] * __expf(gi1 - gj1) : 0.f;
        }
        int lane_o = lane; asm volatile("" : "+v"(lane_o));
        float Tr[64];
#pragma unroll
        for (int m = 0; m < 64; ++m) Tr[m] = 0.f;
        Tr[63] = (lane_o == 63) ? 1.f : 0.f;
        {
            LAS float* mb = Mt + 256 * hh + r;
#pragma unroll
            for (int i = 0; i < 16; ++i) {
                const int cc = (i & 3) + 8 * (i >> 2);
                mb[cc * 64] = m00[i]; mb[cc * 64 + 32] = m10[i]; mb[(32 + cc) * 64 + 32] = m11[i];
            }
        }
        LDS_WAIT(); asm volatile("" ::: "memory");
#ifndef DG_NOSUBST
        { const LAS float* Mt_o = Mt; asm volatile("" : "+v"(Mt_o));
          SubstOuter<62>::run(Tr, Mt_o, lane_o); }
#endif
        LDS_WAIT(); asm volatile("" ::: "memory");
        bf16x8 Tf[2][4];
#pragma unroll
        for (int s = 0; s < 4; ++s) {
            v4u X = pack8(Tr[16 * s], Tr[16 * s + 1], Tr[16 * s + 2], Tr[16 * s + 3], Tr[16 * s + 4], Tr[16 * s + 5], Tr[16 * s + 6], Tr[16 * s + 7]);
            v4u Y = pack8(Tr[16 * s + 8], Tr[16 * s + 9], Tr[16 * s + 10], Tr[16 * s + 11], Tr[16 * s + 12], Tr[16 * s + 13], Tr[16 * s + 14], Tr[16 * s + 15]);
#pragma unroll
            for (int d = 0; d < 4; ++d) { const auto sw = __builtin_amdgcn_permlane32_swap(X[d], Y[d], false, false); X[d] = sw[0]; Y[d] = sw[1]; }
            Tf[0][s] = __builtin_bit_cast(bf16x8, X); Tf[1][s] = __builtin_bit_cast(bf16x8, Y);
        }
#pragma unroll
        for (int c = 0; c < 4; ++c) {
            f32x16 u0, u1;
#pragma unroll
            for (int i = 0; i < 16; ++i) { u0[i] = 0.f; u1[i] = 0.f; }
#pragma unroll
            for (int s = 0; s < 4; ++s) { const bf16x8 vb = ldfrag(VB, s * 4 + c, lane); if (s < 2) u0 = MFMA32(Tf[0][s], vb, u0); u1 = MFMA32(Tf[1][s], vb, u1); }
#pragma unroll
            for (int q = 0; q < 2; ++q) {
                UU[((0 * 4 + c) * 2 + q) * 64 + lane] = (v4u){pk2(u0[8 * q], u0[8 * q + 1]), pk2(u0[8 * q + 2], u0[8 * q + 3]), pk2(u0[8 * q + 4], u0[8 * q + 5]), pk2(u0[8 * q + 6], u0[8 * q + 7])};
                UU[((1 * 4 + c) * 2 + q) * 64 + lane] = (v4u){pk2(u1[8 * q], u1[8 * q + 1]), pk2(u1[8 * q + 2], u1[8 * q + 3]), pk2(u1[8 * q + 4], u1[8 * q + 5]), pk2(u1[8 * q + 6], u1[8 * q + 7])}; }
        }
#pragma unroll
        for (int c = 0; c < 4; ++c) {
            f32x16 w0, w1;
#pragma unroll
            for (int i = 0; i < 16; ++i) { w0[i] = 0.f; w1[i] = 0.f; }
#pragma unroll
            for (int s = 0; s < 4; ++s) { const bf16x8 kb = ldfrag(KBT, c * 4 + s, lane); if (s < 2) w0 = MFMA32(kb, Tf[0][s], w0); w1 = MFMA32(kb, Tf[1][s], w1); }
#pragma unroll
            for (int i = 0; i < 16; ++i) { w0[i] = -w0[i]; w1[i] = -w1[i]; }
            stfrag(WN, (0 * 4 + c) * 2 + 0, lane, __builtin_bit_cast(v4u, packacc(w0, 0))); stfrag(WN, (0 * 4 + c) * 2 + 1, lane, __builtin_bit_cast(v4u, packacc(w0, 1)));
            stfrag(WN, (1 * 4 + c) * 2 + 0, lane, __builtin_bit_cast(v4u, packacc(w1, 0))); stfrag(WN, (1 * 4 + c) * 2 + 1, lane, __builtin_bit_cast(v4u, packacc(w1, 1)));
        }
    }
}

constexpr int SC_BUF = 56320;
constexpr int SC_SSL = 2 * SC_BUF;
__device__ __forceinline__ bf16x8 ldsfrag(const LAS unsigned char* buf, int frag, int lane) { return *(const LAS bf16x8*)(buf + frag * 1024 + lane * 16); }
__device__ __forceinline__ void scan_stage(unsigned char* ws, LAS unsigned char* dst, int u, int lw, int lane) {
    const unsigned char* wn = ws + WS_G_WN + (size_t)u * GU_FR; const unsigned char* qa = ws + WS_G_QA + (size_t)u * GU_FR;
    const unsigned char* kd = ws + WS_G_KDT + (size_t)u * GU_FR; const unsigned char* qk = ws + WS_G_QKM + (size_t)u * 6144;
    v4u v[14];
#pragma unroll
    for (int i = 0; i < 14; ++i) {
        const int f = lw + 4 * i;
        if (f < 54) { const unsigned char* src = f < 16 ? wn + f * 1024 : f < 32 ? qa + (f - 16) * 1024 : f < 48 ? kd + (f - 32) * 1024 : qk + (f - 48) * 1024;
            v[i] = *(const v4u*)(src + lane * 16); }
    }
    float gcv = 0.f;
    if (lw == 0) gcv = ((const float*)(ws + WS_G_GC))[(size_t)u * 64 + lane];
#pragma unroll
    for (int i = 0; i < 14; ++i) { const int f = lw + 4 * i; if (f < 54) *(LAS v4u*)(dst + f * 1024 + lane * 16) = v[i]; }
    if (lw == 0) ((LAS float*)(dst + 54 * 1024))[lane] = gcv;
    LDS_WAIT();
}
__device__ __forceinline__ void phase_gdn_scan(const Args& a, LAS unsigned char* lds, int lane, int wave) {
    unsigned char* ws = a.ws;
    const bf16* projb = (const bf16*)(ws + WS_PROJ); unsigned char* cat8 = ws + WS_CAT; const float* norm_w = a.in[5];
    LAS float* ssl = (LAS float*)(lds + SC_SSL);
    const int r = lane & 31, hh = lane >> 5, cs = wave & 3;
    const bool active = wave < 4;
    for (int bh = blockIdx.x; bh < NB * GH; bh += gridDim.x) {
        const int b = bh >> 4, h = bh & 15;
        f32x16 St[4];
#pragma unroll
        for (int cp = 0; cp < 4; ++cp)
#pragma unroll
            for (int i = 0; i < 16; ++i) St[cp][i] = 0.f;
        f32x4 nw[4];
#pragma unroll
        for (int g = 0; g < 4; ++g) nw[g] = *(const f32x4*)(norm_w + 32 * cs + 8 * g + 4 * hh);
        v4u un[2][2];
        if (active) {
            const v4u* UU = (const v4u*)(ws + WS_G_UU) + (size_t)(bh * 32) * 1024;
#pragma unroll
            for (int I = 0; I < 2; ++I)
#pragma unroll
                for (int q = 0; q < 2; ++q) un[I][q] = UU[((I * 4 + cs) * 2 + q) * 64 + lane];
        } else {
            scan_stage(ws, lds, bh * 32, wave - 4, lane);
        }
        __syncthreads();
        for (int c = 0; c < 32; ++c) {
            const int u = bh * 32 + c, buf = c & 1;
            f32x16 oT[2];
            unsigned long long zz[2][4];
            if (active) {
                const LAS unsigned char* B = lds + buf * SC_BUF;
                const LAS float* GC = (const LAS float*)(B + 54 * 1024);
                f32x16 vn[2];
#pragma unroll
                for (int I = 0; I < 2; ++I)
#pragma unroll
                    for (int q = 0; q < 2; ++q)
#pragma unroll
                        for (int j = 0; j < 4; ++j) { vn[I][8 * q + 2 * j] = bflo(un[I][q][j]); vn[I][8 * q + 2 * j + 1] = bfhi(un[I][q][j]); }
                if (c + 1 < 32) {
                    const v4u* UU = (const v4u*)(ws + WS_G_UU) + (size_t)(u + 1) * 1024;
#pragma unroll
                    for (int I = 0; I < 2; ++I)
#pragma unroll
                        for (int q = 0; q < 2; ++q) un[I][q] = UU[((I * 4 + cs) * 2 + q) * 64 + lane];
                }
#pragma unroll
                for (int I = 0; I < 2; ++I)
#pragma unroll
                    for (int g = 0; g < 4; ++g)
                        zz[I][g] = *(const unsigned long long*)(projb + (size_t)(b * S + c * 64 + 32 * I + r) * NP + Z0 + h * GD + 32 * cs + 8 * g + 4 * hh);
                bf16x8 Sf[4][2];
#pragma unroll
                for (int cp = 0; cp < 4; ++cp) { Sf[cp][0] = packacc(St[cp], 0); Sf[cp][1] = packacc(St[cp], 1); }
#pragma unroll
                for (int I = 0; I < 2; ++I) {
#pragma unroll
                    for (int i = 0; i < 16; ++i) oT[I][i] = 0.f;
#pragma unroll
                    for (int cp = 0; cp < 4; ++cp)
#pragma unroll
                        for (int sp = 0; sp < 2; ++sp) {
                            vn[I] = MFMA32(ldsfrag(B, (I * 4 + cp) * 2 + sp, lane), Sf[cp][sp], vn[I]);
                            oT[I] = MFMA32(Sf[cp][sp], ldsfrag(B, 16 + I * 8 + 2 * cp + sp, lane), oT[I]);
                        }
                    const float eg = __expf(GC[32 * I + r]);
#pragma unroll
                    for (int i = 0; i < 16; ++i) oT[I][i] *= eg;
                }
                bf16x8 Vf[2][2];
#pragma unroll
                for (int J = 0; J < 2; ++J) { Vf[J][0] = packacc(vn[J], 0); Vf[J][1] = packacc(vn[J], 1); }
#pragma unroll
                for (int sp = 0; sp < 2; ++sp) {
                    oT[0] = MFMA32(Vf[0][sp], ldsfrag(B, 48 + 0 + sp, lane), oT[0]);
                    oT[1] = MFMA32(Vf[0][sp], ldsfrag(B, 48 + 2 + sp, lane), oT[1]);
                    oT[1] = MFMA32(Vf[1][sp], ldsfrag(B, 48 + 4 + sp, lane), oT[1]);
                }
                const float dec = __expf(GC[63]);
#pragma unroll
                for (int cp = 0; cp < 4; ++cp) {
#pragma unroll
                    for (int i = 0; i < 16; ++i) St[cp][i] *= dec;
#pragma unroll
                    for (int J = 0; J < 2; ++J)
#pragma unroll
                        for (int sp = 0; sp < 2; ++sp) St[cp] = MFMA32(ldsfrag(B, 32 + cp * 4 + J * 2 + sp, lane), Vf[J][sp], St[cp]);
                }
#pragma unroll
                for (int I = 0; I < 2; ++I) {
                    float ss = 0.f;
#pragma unroll
                    for (int i = 0; i < 16; ++i) ss = fmaf(oT[I][i], oT[I][i], ss);
                    ss += __shfl_xor(ss, 32);
                    if (hh == 0) ssl[(buf * 4 + cs) * 64 + 32 * I + r] = ss;
                }
            } else if (c + 1 < 32) {
                scan_stage(ws, lds + (buf ^ 1) * SC_BUF, u + 1, wave - 4, lane);
            }
            __syncthreads();
            if (active) {
#pragma unroll
                for (int I = 0; I < 2; ++I) {
                    const int tok = 32 * I + r, t = b * S + c * 64 + tok;
                    const float tot = ssl[(buf * 4 + 0) * 64 + tok] + ssl[(buf * 4 + 1) * 64 + tok] + ssl[(buf * 4 + 2) * 64 + tok] + ssl[(buf * 4 + 3) * 64 + tok];
                    const float rstd = rsqrtf(tot * (1.f / GD) + RMS_EPS);
#pragma unroll
                    for (int g = 0; g < 4; ++g) {
                        const int dv = 32 * cs + 8 * g + 4 * hh;
                        const unsigned z01 = (unsigned)zz[I][g], z23 = (unsigned)(zz[I][g] >> 32);
                        const float o0 = oT[I][4 * g] * rstd * nw[g][0] * silu_f(bflo(z01)), o1 = oT[I][4 * g + 1] * rstd * nw[g][1] * silu_f(bfhi(z01));
                        const float o2 = oT[I][4 * g + 2] * rstd * nw[g][2] * silu_f(bflo(z23)), o3 = oT[I][4 * g + 3] * rstd * nw[g][3] * silu_f(bfhi(z23));
                        *(unsigned*)(cat8 + (size_t)t * D + h * GD + dv) = pk4_fp8(o0, o1, o2, o3);
                    }
                }
            }
        }
        __syncthreads();
    }
}


#define XB_TMO      128
#define XB_XCNT(j)  (256  + 64 * (j))
#define XB_XSUB(j)  (1280 + 64 * (j))
#define XB_XGEN(j)  (2304 + 64 * (j))
#define XB_TOP      3328
#define XB_TOPGEN   3392
#define XCD_BAR_WORDS 3456
#define XB_SPIN_CAP (1u << 18)

__device__ __forceinline__ unsigned xb_ld(unsigned* p)              { return __hip_atomic_load(p, __ATOMIC_RELAXED, __HIP_MEMORY_SCOPE_AGENT); }
__device__ __forceinline__ unsigned xb_add(unsigned* p, unsigned v) { return __hip_atomic_fetch_add(p, v, __ATOMIC_RELAXED, __HIP_MEMORY_SCOPE_AGENT); }
__device__ __forceinline__ unsigned xb_xcc_id() { return (unsigned)__builtin_amdgcn_s_getreg((3 << 11) | 20) & 0xFu; }
#define XB_SPIN(cond, bar) do { unsigned _sp = 0; while (cond) { __builtin_amdgcn_s_sleep(1); \
    if ((++_sp & 255u) == 0u) { if (xb_ld(&(bar)[XB_TMO])) break; if (_sp > XB_SPIN_CAP) { atomicAdd(&(bar)[XB_TMO], 1u); break; } } } } while (0)

struct XcdBarrier {
    unsigned* bar; unsigned x;
    volatile LAS unsigned* st;
};

__device__ __forceinline__ XcdBarrier xcd_barrier_post(unsigned* bar, volatile LAS unsigned* st) {
    XcdBarrier b; b.bar = bar; b.x = xb_xcc_id(); b.st = st;
    if (threadIdx.x == 0) (void)xb_add(&bar[XB_XCNT(b.x)], 1u);
    return b;
}
__device__ __forceinline__ void xcd_barrier_complete(unsigned* bar, unsigned x, unsigned& nloc, unsigned& nx) {
    const unsigned G = gridDim.x * gridDim.y * gridDim.z;
    unsigned sum, cnt, mine, sp = 0u;
    for (;;) {
        sum = 0u; cnt = 0u; mine = 0u;
#pragma unroll
        for (unsigned j = 0; j < 16; ++j) { const unsigned c = xb_ld(&bar[XB_XCNT(j)]); sum += c; cnt += (c > 0u) ? 1u : 0u; mine = (j == x) ? c : mine; }
        if (sum == G) break;
        __builtin_amdgcn_s_sleep(1);
        if ((++sp & 255u) == 0u) { if (xb_ld(&bar[XB_TMO])) break; if (sp > XB_SPIN_CAP) { atomicAdd(&bar[XB_TMO], 1u); break; } }
    }
    nloc = mine > 0u ? mine : 1u; nx = cnt > 0u ? cnt : 1u;
}

__device__ __forceinline__ void xcd_barrier(const XcdBarrier& b, int tid_in = -1) {
    const int tid_ = tid_in < 0 ? (int)threadIdx.x : tid_in;
    asm volatile("s_waitcnt vmcnt(0)" ::: "memory");
    __syncthreads();
    if (tid_ == 0) {
        unsigned* bar = b.bar;
        __builtin_amdgcn_s_waitcnt(0);
        unsigned nloc = b.st[0], nx = b.st[1];
        if (nloc == 0u) { xcd_barrier_complete(bar, b.x, nloc, nx); b.st[0] = nloc; b.st[1] = nx; }
        const unsigned old = xb_add(&bar[XB_XSUB(b.x)], 1u);
        const unsigned gen = old / nloc;
        if (old + 1u == (gen + 1u) * nloc) {
            __builtin_amdgcn_fence(__ATOMIC_RELEASE, "agent");
            asm volatile("s_waitcnt vmcnt(0)" ::: "memory");
            const unsigned og = xb_add(&bar[XB_TOP], 1u);
            const unsigned tg = og / nx;
            if (og + 1u == (tg + 1u) * nx) xb_add(&bar[XB_TOPGEN], 1u);
            else XB_SPIN(xb_ld(&bar[XB_TOPGEN]) == tg, bar);
            __builtin_amdgcn_fence(__ATOMIC_ACQUIRE, "agent");
            xb_add(&bar[XB_XGEN(b.x)], 1u);
            asm volatile("s_waitcnt vmcnt(0)" ::: "memory");
        } else {
            XB_SPIN(xb_ld(&bar[XB_XGEN(b.x)]) == gen, bar);
            __builtin_amdgcn_fence(__ATOMIC_ACQUIRE, "agent");
            asm volatile("s_waitcnt vmcnt(0)" ::: "memory");
        }
    }
    __syncthreads();
}

__global__ void __launch_bounds__(NTHREADS, 2) mk(Args a) {
    extern __shared__ __attribute__((aligned(16))) unsigned char lds_raw[];
    LAS unsigned char* lds = (LAS unsigned char*)lds_raw;
    cg::grid_group grid = cg::this_grid();
    const int tid = threadIdx.x, lane = tid & 63, wave = __builtin_amdgcn_readfirstlane(tid >> 6);
    volatile LAS unsigned* misc = (volatile LAS unsigned*)(lds + LDS_BYTES - 256);
    if (tid < 64) misc[tid] = 0u;
    __syncthreads();
    const XcdBarrier xbar = xcd_barrier_post((unsigned*)(a.ws + WS_CTL), misc);
    const int lo = a.ph_lo, hi = a.ph_hi;
    unsigned char* ws = a.ws;
#define IN(k) (lo <= (k) && (k) < hi)
#define SEAM(k) do { if (IN(k) && IN((k) + 1)) { if ((k) == 0 && lo < 0) grid.sync(); else xcd_barrier(xbar); } } while (0)
#define SEAM1(k) do { if (IN(k) && IN((k) + 1)) xcd_barrier(xbar, tid1); } while (0)
#define SEAM2(k) do { if (IN(k) && IN((k) + 1)) xcd_barrier(xbar, tid2); } while (0)
#define LOCAL_SEAM(k) do { if (IN(k) && IN((k) + 1)) { asm volatile("s_waitcnt vmcnt(0)" ::: "memory"); __syncthreads(); } } while (0)
    if (IN(0)) { phase0(a, lds, tid, lane, wave); }
    SEAM(0);
    if (IN(1)) {
        rescale_rows_fp8(ws + WS_WIN8, (const signed char*)(ws + WS_ETAB_IN), (float*)(ws + WS_SWIN), (const unsigned*)(ws + WS_CTL + CTL_WIMAX), NP, 1.f / XQ_SCALE, lane, wave);
        if constexpr (F8N < NP) {
            pg8::Gemm g{(const bf16*)(ws + WS_XB), (const bf16*)(ws + WS_WIN), T, NP - F8N, D}; pg8::StaticOrderSkip S; S.init(T, NP - F8N, (int)gridDim.x, (int)blockIdx.x); S.s0 = F8C0 / 256; S.sn = F8N / 256;
            EpiBf16 E{(bf16*)(ws + WS_PROJ), NP};
            pg8::gemm_phase<EpiBf16, pg8::StaticOrderSkip, true, true>(lds, g, S, E);
        }
        xcd_barrier(xbar);
        {
            pg8::Gemm g{(const bf16*)(ws + WS_XQ8), (const bf16*)(ws + WS_WIN8), T, F8N, D}; pg8::StaticOrder S; S.init(T, F8N, (int)gridDim.x, (int)blockIdx.x);
            EpiBf16Res E{(bf16*)(ws + WS_PROJ) + F8C0, nullptr, NP, 0.f, (const float*)(ws + WS_SWIN)};
            pg8::gemm_phase<EpiBf16Res, pg8::StaticOrder, true, true, true>(lds, g, S, E);
        }
    }
    int lane1; asm volatile("v_mbcnt_lo_u32_b32 %0, -1, 0\n\tv_mbcnt_hi_u32_b32 %0, -1, %0" : "=v"(lane1));
    const int tid1 = (wave * 64 + lane1) & 511;
    SEAM1(1);
    if (IN(2)) { phase_gdn_prep(a, lds, tid1, lane1, wave); }
    LOCAL_SEAM(2);
    if (IN(3)) { phase_gdn_solve(a, lds, lane1, wave); }
    SEAM1(3);
    if (IN(4)) {
        if ((int)blockIdx.x < NB * GH) phase_gdn_scan(a, lds, lane1, wave);
        if ((int)gridDim.x <= NB * GH) p0_tables(a, lds, lane1, wave, 0, (int)gridDim.x, 0, TBL_GROUPS);
        else if ((int)blockIdx.x >= NB * GH) p0_tables(a, lds, lane1, wave, NB * GH, (int)gridDim.x - NB * GH, 0, TBL_GROUPS);
    }
    SEAM1(4);
    if (IN(5)) {
        pg8::Gemm g{(const bf16*)(ws + WS_CAT), (const bf16*)(ws + WS_WOUT8), T, D, D}; pg8::StaticOrder S; S.init(T, D, (int)gridDim.x, (int)blockIdx.x);
        EpiBf16Res E{(bf16*)(ws + WS_PRE1), a.in[0], D, ALPHA, (const float*)(ws + WS_SWOUT)};
        pg8::gemm_phase<EpiBf16Res, pg8::StaticOrder, true, false, true>(lds, g, S, E, tid1);
    }
    int lane2; asm volatile("v_mbcnt_lo_u32_b32 %0, -1, 0\n\tv_mbcnt_hi_u32_b32 %0, -1, %0" : "=v"(lane2));
    const int tid2 = (wave * 64 + lane2) & 511;
    SEAM2(5);
    if (IN(6)) { phase_ln1(a, lane2, wave); }
    SEAM2(6);
    if (IN(7)) {
        pg8::Gemm g{(const bf16*)(ws + WS_X1B), (const bf16*)(ws + WS_WQ), T, NQ, D}; pg8::StaticOrder S; S.init(T, NQ, (int)gridDim.x, (int)blockIdx.x);
        EpiBf16 E{(bf16*)(ws + WS_QPB), NQ};
        pg8::gemm_phase<EpiBf16, pg8::StaticOrder, true, true>(lds, g, S, E, tid2);
    }
    SEAM2(7);
    if (IN(8)) { phase_route(a, lane2, wave); }
    LOCAL_SEAM(8);
    if (IN(9)) { phase_expert_down<0>(a, lane2, wave); }
    LOCAL_SEAM(9);
    if (IN(10)) { phase_expert_up<0>(a, lds, lane2, wave); }
#undef IN
#undef SEAM
}

static int g_grid = 0;
static void launch_mk(const Args& base, int lo, int hi, hipStream_t stream) {
    Args a = base; a.ph_lo = lo; a.ph_hi = hi;
    void* params[] = {&a};
    hipError_t e = hipLaunchCooperativeKernel((const void*)mk, dim3(g_grid), dim3(NTHREADS), params, LDS_BYTES, stream);
    if (e != hipSuccess) fprintf(stderr, "kernel_launch: cooperative launch [%d,%d) failed: %s (grid %d)\n", lo, hi, hipGetErrorString(e), g_grid);
}

extern "C" void kernel_launch(void* const* d_in, const int* in_sizes, int n_in, void* d_out, int out_size, void* d_ws, size_t ws_size,
                              hipStream_t stream) {
    (void)in_sizes; (void)n_in; (void)out_size;
    if (!g_grid) {
        int dev = 0, cus = 0, per_cu = 0;
        hipGetDevice(&dev);
        hipDeviceGetAttribute(&cus, hipDeviceAttributeMultiprocessorCount, dev);
        hipFuncSetAttribute((const void*)mk, hipFuncAttributeMaxDynamicSharedMemorySize, LDS_BYTES);
        hipOccupancyMaxActiveBlocksPerMultiprocessor(&per_cu, (const void*)mk, NTHREADS, LDS_BYTES);
        if (per_cu < 1) { fprintf(stderr, "kernel_launch: occupancy query says %d blocks/CU\n", per_cu); per_cu = 1; }
        g_grid = cus * 1;
        if (ws_size < WS_END) fprintf(stderr, "kernel_launch: workspace too small: %zu < %zu\n", ws_size, (size_t)WS_END);
    }
    Args a{};
    for (int i = 0; i < 16; ++i) a.in[i] = (const float*)d_in[i];
    a.out = (float*)d_out; a.ws = (unsigned char*)d_ws; a.ph_lo = 0; a.ph_hi = 0;
    unsigned char* ws = (unsigned char*)d_ws;

    (void)hipMemsetAsync(d_ws, 0, CTL_BYTES, stream);
    launch_mk(a, 0, 11, stream);
}
```

```cpp
#include <hip/hip_runtime.h>
#include <hip/hip_cooperative_groups.h>
#include <stdint.h>
#include <cstdio>
namespace cg = cooperative_groups;

namespace cfg {
constexpr int D = 4096, NB = 4, S = 2048, T = NB * S;
constexpr int GH = 16, GD = 128, GW = 2048;
constexpr int NIN = 14368;
constexpr int NP = 14336;
constexpr int Q0 = 0, K0 = 2048, V0 = 4096, Z0 = 6144, BETA0 = 8192, A0 = 8208;
constexpr int PGB0 = 8192, PGC0 = 10240, PH0 = 12288;
constexpr int PH = 8, PK = 16, PN = 128, PQ = 256;
constexpr int NQ = PH * PQ;
constexpr int NE = 16384;
constexpr float ALPHA = 1.189207115002721f;
constexpr float LN_EPS = 1e-5f, RMS_EPS = 1e-6f;
}
using namespace cfg;
namespace pg8 {
#define PG8_LAS __attribute__((address_space(3)))
typedef unsigned short bf16_t;
typedef short bf16x8 __attribute__((ext_vector_type(8)));
typedef float f32x4 __attribute__((ext_vector_type(4)));
typedef unsigned u32x4 __attribute__((ext_vector_type(4)));
constexpr int BM = 256, BK = 64, HALF = 128, HTB = HALF * BK * 2  , STAGE_BYTES = 8 * HTB, NXCD = 8, WGM = 4;

__host__ __device__ __forceinline__ int lds_byte(int r, int c) { const int st = (r >> 4) * 2 + (c >> 5), rr = r & 15, cc = c & 31, ob = rr * 64 + cc * 2; return st * 1024 + (ob ^ (((ob >> 9) & 1) << 5)); }
__host__ __device__ __forceinline__ void stage_rc(int b, int& R, int& C) { const int st = b / 1024, sb = b % 1024, swz = sb ^ (((sb >> 9) & 1) << 5); R = (st >> 1) * 16 + swz / 64; C = (st & 1) * 32 + (swz % 64) / 2; }
__host__ __device__ __forceinline__ int perm32(int rho) { const int n = rho >> 4, i = rho & 15; return 8 * (i >> 2) + 4 * n + (i & 3); }

struct Unit { int pm, pn; };
struct Gemm { const bf16_t* A; const bf16_t* Bt; int M, N, K; };

struct StaticOrder {
    int nM, nN, nwg, G, c;
    __host__ __device__ void init(int M, int N, int G_, int c_) { nM = M / BM; nN = N / BM; nwg = nM * nN; G = G_; c = c_; }
    __host__ __device__ bool next(int i, Unit& u) const {
        const long L = (long)i * G + c; if (L >= nwg) return false;
        int wgid = (int)L; { const int q = nwg / NXCD, r = nwg % NXCD, xcd = wgid % NXCD, off = wgid / NXCD; wgid = (xcd < r ? xcd * (q + 1) : r * (q + 1) + (xcd - r) * q) + off; }
        const int nig = WGM * nN, gid = wgid / nig, fm = gid * WGM, gsz = (nM - fm) < WGM ? (nM - fm) : WGM;
        u.pm = fm + ((wgid % nig) % gsz); u.pn = (wgid % nig) / gsz; return true;
    }
    __device__ __forceinline__ void a_ready(const Unit&) const {}
    __device__ __forceinline__ void done(const Unit&) const {}
};
struct StaticOrderSkip : StaticOrder {
    int s0, sn;
    __host__ __device__ bool next(int i, Unit& u) const { if (!StaticOrder::next(i, u)) return false; if (u.pn >= s0) u.pn += sn; return true; }
};
__device__ __forceinline__ unsigned cvt_pk_bf16(float lo, float hi) { unsigned r; asm volatile("v_cvt_pk_bf16_f32 %0, %1, %2" : "=v"(r) : "v"(lo), "v"(hi)); return r; }
typedef float f32x2 __attribute__((ext_vector_type(2)));
typedef int i32x8 __attribute__((ext_vector_type(8)));
template <class Epi, class Sched, bool ALIGN_EPI = false, bool SP2 = false, bool F8 = false>
__device__ __forceinline__ void gemm_phase(PG8_LAS unsigned char* lds, const Gemm g, const Sched& S, const Epi& E, int tid_in = -1) {
    const int tid = tid_in < 0 ? (int)threadIdx.x : tid_in, wid = __builtin_amdgcn_readfirstlane(tid >> 6), lane = tid & 63, wr = wid >> 2, wc = wid & 3, fr = lane & 15, fq = lane >> 4;
    const int K = F8 ? g.K / 2 : g.K, nt = K / BK;
    unsigned voffA[2], voffB[2];
#pragma unroll
    for (int i = 0; i < 2; ++i) { int R, C; stage_rc(tid * 16 + i * 8192, R, C); const int Rb = Epi::PERM ? ((R & ~31) + perm32(R & 31)) : R;
        voffA[i] = (unsigned)(R * K + C) * 2u; voffB[i] = (unsigned)(Rb * K + C) * 2u; }
    const size_t kstep = (size_t)(BK * 2);
    const size_t hstep = (size_t)HALF * K * 2;
    const size_t tstep = 2 * hstep;
    const unsigned ldsw = (unsigned)wid * 1024u;
    const int aoff = lds_byte(wr * 64 + fr, F8 ? fq * 16 : fq * 8), boff = lds_byte(wc * 32 + fr, F8 ? fq * 16 : fq * 8);
    const int aoff1 = aoff + (F8 ? 16 : 1024), boff1 = boff + (F8 ? 16 : 1024);
#define PG8_SA(b, h) (((b) * 2 + (h)) * HTB)
#define PG8_SB(b, h) ((4 + (b) * 2 + (h)) * HTB)
    const __amdgpu_buffer_rsrc_t rsA = __builtin_amdgcn_make_buffer_rsrc((void*)g.A, 0, 0x7fffffff, 0x00020000), rsB = __builtin_amdgcn_make_buffer_rsrc((void*)g.Bt, 0, 0x7fffffff, 0x00020000);
#define PG8_STAGE(bufoff, gbase, voff) do { const bool isA_ = ((const unsigned*)(voff) == (const unsigned*)voffA); \
        const int so_ = (int)((const char*)(gbase) - (const char*)(isA_ ? (const void*)g.A : (const void*)g.Bt)); \
        _Pragma("unroll") for (int _i = 0; _i < 2; ++_i)        \
        __builtin_amdgcn_raw_ptr_buffer_load_lds(isA_ ? rsA : rsB, (PG8_LAS unsigned*)(lds + (bufoff) + ldsw + _i * 8192), 16, (int)(voff)[0], so_ + _i * 64 * K * 2, 0, 0); } while (0)
#define PG8_LDA(dst, b, h) do { _Pragma("unroll") for (int m = 0; m < 4; ++m) dst[m] = __builtin_shufflevector(*(const PG8_LAS bf16x8*)(lds + PG8_SA(b, h) + aoff + m * 2048), *(const PG8_LAS bf16x8*)(lds + PG8_SA(b, h) + aoff1 + m * 2048), 0, 1, 2, 3, 4, 5, 6, 7, 8, 9, 10, 11, 12, 13, 14, 15); } while (0)
#define PG8_LDB(dst, b, h) do { _Pragma("unroll") for (int n = 0; n < 2; ++n) dst[n] = __builtin_shufflevector(*(const PG8_LAS bf16x8*)(lds + PG8_SB(b, h) + boff + n * 2048), *(const PG8_LAS bf16x8*)(lds + PG8_SB(b, h) + boff1 + n * 2048), 0, 1, 2, 3, 4, 5, 6, 7, 8, 9, 10, 11, 12, 13, 14, 15); } while (0)
#define PG8_MMA(ai, bj, At, Bt) do { __builtin_amdgcn_s_setprio(1); _Pragma("unroll") for (int m = 0; m < 4; ++m) _Pragma("unroll") for (int n = 0; n < 2; ++n) { \
        if constexpr (F8) { \
            acc[ai][bj][m][n] = __builtin_amdgcn_mfma_scale_f32_16x16x128_f8f6f4(__builtin_bit_cast(i32x8, Bt[n]), __builtin_bit_cast(i32x8, At[m]), acc[ai][bj][m][n], 0, 0, 0, 0x7f7f7f7f, 0, 0x7f7f7f7f); \
        } else { \
            acc[ai][bj][m][n] = __builtin_amdgcn_mfma_f32_16x16x32_bf16(__builtin_shufflevector(Bt[n], Bt[n], 0, 1, 2, 3, 4, 5, 6, 7), __builtin_shufflevector(At[m], At[m], 0, 1, 2, 3, 4, 5, 6, 7), acc[ai][bj][m][n], 0, 0, 0); \
            acc[ai][bj][m][n] = __builtin_amdgcn_mfma_f32_16x16x32_bf16(__builtin_shufflevector(Bt[n], Bt[n], 8, 9, 10, 11, 12, 13, 14, 15), __builtin_shufflevector(At[m], At[m], 8, 9, 10, 11, 12, 13, 14, 15), acc[ai][bj][m][n], 0, 0, 0); } } \
        __builtin_amdgcn_s_setprio(0); } while (0)
#define PG8_WAIT_V(n) asm volatile("s_waitcnt vmcnt(" #n ")" ::: "memory")
#define PG8_WAIT_L(n) asm volatile("s_waitcnt lgkmcnt(" #n ")" ::: "memory")
#define PG8_BAR __builtin_amdgcn_s_barrier()
#define PG8_SCHED __builtin_amdgcn_sched_barrier(0)
    Unit cur, nxt; int ui = 0;
    if (!S.next(0, cur)) return;
    f32x4 acc[2][2][4][2];
#pragma unroll
    for (int a = 0; a < 2; ++a)
#pragma unroll
        for (int b = 0; b < 2; ++b)
#pragma unroll
            for (int m = 0; m < 4; ++m)
#pragma unroll
                for (int n = 0; n < 2; ++n) acc[a][b][m][n] = (f32x4){0.f, 0.f, 0.f, 0.f};
    typedef short s16x16 __attribute__((ext_vector_type(16)));
    s16x16 At[4], B0[2], B1[2];
    const char* cA = (const char*)g.A + (size_t)cur.pm * tstep; const char* cB = (const char*)g.Bt + (size_t)cur.pn * tstep;
    S.a_ready(cur);
    if constexpr (SP2) {
        PG8_STAGE(PG8_SB(0, 0), cB, voffB); PG8_STAGE(PG8_SB(0, 1), cB + hstep, voffB); PG8_STAGE(PG8_SA(0, 0), cA, voffA); PG8_STAGE(PG8_SA(0, 1), cA + hstep, voffA);
        if (wr == 1) PG8_BAR;
        PG8_WAIT_V(2); PG8_BAR;
        PG8_STAGE(PG8_SB(1, 0), cB + kstep, voffB); PG8_STAGE(PG8_SA(1, 0), cA + kstep, voffA); PG8_STAGE(PG8_SB(1, 1), cB + hstep + kstep, voffB);
        PG8_WAIT_V(6); PG8_BAR;
    } else {
        PG8_STAGE(PG8_SB(0, 0), cB, voffB); PG8_STAGE(PG8_SA(0, 0), cA, voffA); PG8_STAGE(PG8_SB(0, 1), cB + hstep, voffB); PG8_STAGE(PG8_SA(0, 1), cA + hstep, voffA);
        if (wr == 1) PG8_BAR;
        PG8_WAIT_V(4); PG8_BAR;
        PG8_STAGE(PG8_SB(1, 0), cB + kstep, voffB); PG8_STAGE(PG8_SA(1, 0), cA + kstep, voffA); PG8_STAGE(PG8_SB(1, 1), cB + hstep + kstep, voffB);
        PG8_WAIT_V(6); PG8_BAR;
    }
    for (;;) {
        const bool has_next = S.next(ui + 1, nxt);
        const char* nA = has_next ? (const char*)g.A + (size_t)nxt.pm * tstep : cA; const char* nB = has_next ? (const char*)g.Bt + (size_t)nxt.pn * tstep : cB;
        for (int t = 0; t < nt; t += 2) {
            const bool last = (t == nt - 2);
            const char* a1 = cA + (size_t)(t + 1) * kstep;
            const char* a2 = last ? nA : cA + (size_t)(t + 2) * kstep; const char* b2 = last ? nB : cB + (size_t)(t + 2) * kstep;
            const char* a3 = a2 + kstep; const char* b3 = b2 + kstep;
            if (last && has_next) S.a_ready(nxt);
            if constexpr (SP2) {
            PG8_LDB(B0, 0, 0); PG8_LDB(B1, 0, 1); PG8_SCHED; PG8_LDA(At, 0, 0); PG8_STAGE(PG8_SA(1, 1), a1 + hstep, voffA);
            PG8_WAIT_V(8); PG8_WAIT_L(0); PG8_BAR; PG8_MMA(0, 0, At, B0); PG8_MMA(0, 1, At, B1); PG8_BAR; PG8_SCHED;
            PG8_LDA(At, 0, 1); PG8_STAGE(PG8_SB(0, 0), b2, voffB); PG8_STAGE(PG8_SB(0, 1), b2 + hstep, voffB); PG8_STAGE(PG8_SA(0, 0), a2, voffA);
            PG8_WAIT_V(8); PG8_WAIT_L(0); PG8_BAR; PG8_MMA(1, 0, At, B0); PG8_MMA(1, 1, At, B1); PG8_BAR; PG8_SCHED;
            PG8_LDB(B0, 1, 0); PG8_LDB(B1, 1, 1); PG8_SCHED; PG8_LDA(At, 1, 0); PG8_STAGE(PG8_SA(0, 1), a2 + hstep, voffA);
            PG8_WAIT_V(8); PG8_WAIT_L(0); PG8_BAR; PG8_MMA(0, 0, At, B0); PG8_MMA(0, 1, At, B1); PG8_BAR; PG8_SCHED;
            PG8_LDA(At, 1, 1); PG8_STAGE(PG8_SB(1, 0), b3, voffB); PG8_STAGE(PG8_SB(1, 1), b3 + hstep, voffB); PG8_STAGE(PG8_SA(1, 0), a3, voffA);
            PG8_WAIT_V(8); PG8_WAIT_L(0); PG8_BAR; PG8_MMA(1, 0, At, B0); PG8_MMA(1, 1, At, B1); PG8_BAR; PG8_SCHED;
            } else {
            PG8_LDB(B0, 0, 0); PG8_SCHED; PG8_LDA(At, 0, 0); PG8_STAGE(PG8_SA(1, 1), a1 + hstep, voffA);
            PG8_WAIT_L(8); PG8_BAR; PG8_WAIT_L(0); PG8_MMA(0, 0, At, B0); PG8_BAR; PG8_SCHED;
            PG8_LDB(B1, 0, 1); PG8_STAGE(PG8_SB(0, 0), b2, voffB);
            PG8_BAR; PG8_WAIT_L(0); PG8_MMA(0, 1, At, B1); PG8_BAR;
            PG8_LDA(At, 0, 1); PG8_STAGE(PG8_SA(0, 0), a2, voffA);
            PG8_BAR; PG8_WAIT_L(0); PG8_MMA(1, 0, At, B0); PG8_BAR; PG8_SCHED;
            PG8_STAGE(PG8_SB(0, 1), b2 + hstep, voffB);
            PG8_WAIT_V(6); PG8_BAR; PG8_MMA(1, 1, At, B1); PG8_BAR;
            PG8_LDB(B0, 1, 0); PG8_SCHED; PG8_LDA(At, 1, 0); PG8_STAGE(PG8_SA(0, 1), a2 + hstep, voffA);
            PG8_WAIT_L(8); PG8_BAR; PG8_WAIT_L(0); PG8_MMA(0, 0, At, B0); PG8_BAR; PG8_SCHED;
            PG8_LDB(B1, 1, 1); PG8_STAGE(PG8_SB(1, 0), b3, voffB);
            PG8_BAR; PG8_WAIT_L(0); PG8_MMA(0, 1, At, B1); PG8_BAR;
            PG8_LDA(At, 1, 1); PG8_STAGE(PG8_SA(1, 0), a3, voffA);
            PG8_BAR; PG8_WAIT_L(0); PG8_MMA(1, 0, At, B0); PG8_BAR; PG8_SCHED;
            PG8_STAGE(PG8_SB(1, 1), b3 + hstep, voffB);
            PG8_WAIT_V(6); PG8_BAR; PG8_MMA(1, 1, At, B1); PG8_BAR;
            }
        }
        if constexpr (ALIGN_EPI) { if (wr == 0) PG8_BAR; }
        if constexpr (!Epi::AFTER_DRAIN) { E(acc, cur, wr, wc, fr, fq); S.done(cur); }
        if (!has_next) break;
#pragma unroll
        for (int a = 0; a < 2; ++a)
#pragma unroll
            for (int b = 0; b < 2; ++b)
#pragma unroll
                for (int m = 0; m < 4; ++m)
#pragma unroll
                    for (int n = 0; n < 2; ++n) acc[a][b][m][n] = (f32x4){0.f, 0.f, 0.f, 0.f};
        cur = nxt; cA = nA; cB = nB; ++ui;
        if constexpr (ALIGN_EPI) { if (wr == 1) PG8_BAR; }
    }
    PG8_WAIT_V(0);
    if constexpr (!ALIGN_EPI) { if (wr == 0) PG8_BAR; }
    PG8_BAR;
    if constexpr (Epi::AFTER_DRAIN) { E.fused(acc, cur, wr, wc, fr, fq, lds, wid, lane); S.done(cur); }
#undef PG8_SA
#undef PG8_SB
#undef PG8_STAGE
#undef PG8_LDA
#undef PG8_LDB
#undef PG8_MMA
#undef PG8_WAIT_V
#undef PG8_WAIT_L
#undef PG8_BAR
#undef PG8_SCHED
}
}

#define LAS __attribute__((address_space(3)))
typedef unsigned short bf16;
typedef unsigned v4u __attribute__((ext_vector_type(4)));
typedef float f32x4 __attribute__((ext_vector_type(4)));
typedef float f32x16 __attribute__((ext_vector_type(16)));
typedef short bf16x8 __attribute__((ext_vector_type(8)));
typedef float f32x2v __attribute__((ext_vector_type(2)));
#define LDS_WAIT() asm volatile("s_waitcnt lgkmcnt(0)" ::: "memory")
#define VM_WAIT() asm volatile("s_waitcnt vmcnt(0)" ::: "memory")
__device__ __forceinline__ unsigned f2bf(float f) { unsigned u = __builtin_bit_cast(unsigned, f); return (u + 0x7fffu + ((u >> 16) & 1u)) >> 16; }
__device__ __forceinline__ unsigned pk2(float lo, float hi) { return f2bf(lo) | (f2bf(hi) << 16); }
__device__ __forceinline__ float clamp448(float v) { return fminf(fmaxf(v, -448.f), 448.f); }
__device__ __forceinline__ unsigned pk4_fp8(float a0, float a1, float a2, float a3) { int p = 0; p = __builtin_amdgcn_cvt_pk_fp8_f32(clamp448(a0), clamp448(a1), p, false); p = __builtin_amdgcn_cvt_pk_fp8_f32(clamp448(a2), clamp448(a3), p, true); return (unsigned)p; }
__device__ __forceinline__ float bf2f(unsigned short b) { return __builtin_bit_cast(float, (unsigned)b << 16); }
__device__ __forceinline__ float bflo(unsigned w) { return __builtin_bit_cast(float, w << 16); }
__device__ __forceinline__ float bfhi(unsigned w) { return __builtin_bit_cast(float, w & 0xffff0000u); }

__device__ __forceinline__ float wave_sum(float v) {
#pragma unroll
    for (int o = 1; o < 64; o <<= 1) v += __shfl_xor(v, o);
    return v;
}
__device__ __forceinline__ float silu_f(float x) { return x * __builtin_amdgcn_rcpf(1.f + __expf(-x)); }
__device__ __forceinline__ float sigmoid_f(float x) { return 1.f / (1.f + expf(-x)); }
__device__ __forceinline__ float softplus_f(float x) { return x > 20.f ? x : log1pf(expf(x)); }
__device__ __forceinline__ float gelu_f(float z) { return 0.5f * z * (1.f + erff(z * 0.7071067811865476f)); }

constexpr size_t al256(size_t x) { return (x + 255) & ~(size_t)255; }
constexpr size_t WS_CTL = 0;
constexpr size_t CTL_WIMAX = 65536;
constexpr size_t CTL_WOMAX = 32768;
constexpr size_t CTL_TBLQ = 126976;
constexpr size_t CTL_BYTES = 131072;
constexpr size_t WS_XB = WS_CTL + CTL_BYTES;
constexpr size_t WS_WIN = WS_XB + al256((size_t)T * D * 2);
constexpr size_t WS_WOUT = WS_WIN + al256((size_t)NP * D * 2);
constexpr size_t WS_WQ = WS_WOUT + al256((size_t)D * D * 2);
constexpr size_t WS_BRAW = WS_WQ + al256((size_t)NQ * D * 2);
constexpr size_t WS_PROJ = WS_BRAW + al256((size_t)T * 32 * 4);
constexpr size_t WS_CAT = WS_PROJ + al256((size_t)T * NP * 2);
constexpr size_t WS_PRE1 = WS_CAT + al256((size_t)T * D * 2);
constexpr size_t WS_X1 = WS_PRE1 + al256((size_t)T * D * 4);
constexpr int F8G0 = 0, F8G1 = 7;
constexpr int F8C0 = F8G0 * 2048, F8C1 = F8G1 * 2048, F8N = F8C1 - F8C0;
constexpr float XQ_SCALE = 16.f;
constexpr size_t WS_XQ8 = WS_X1;
constexpr size_t WS_WIN8 = WS_XQ8 + al256((size_t)T * D);
constexpr size_t WS_SWIN = WS_WIN8 + al256((size_t)F8N * D);
static_assert(WS_SWIN + F8N * 4 <= WS_X1 + (size_t)T * D * 4, "fp8 in-projection operands must fit in the X1 region");
constexpr size_t WS_ETAB_IN = WS_WIN;
constexpr size_t WS_ETAB_OUT = WS_ETAB_IN + al256((size_t)NP * 64);
static_assert(F8G0 == 0 && F8G1 == 7, "the fp8 transposes cover the whole in-projection");
constexpr size_t WS_X1B = WS_X1 + al256((size_t)T * D * 4);
constexpr size_t WS_QPB = WS_X1B + al256((size_t)T * D * 2);
constexpr size_t WS_KEYSB = WS_QPB + al256((size_t)T * NQ * 2);
constexpr size_t WS_EIDX = WS_KEYSB + al256((size_t)PH * 2 * PN * 128 * 2);
constexpr size_t WS_EGATE = WS_EIDX + al256((size_t)T * PH * PK * 4);
constexpr size_t WS_WD8 = WS_EGATE + al256((size_t)T * PH * PK * 4);
constexpr size_t WS_WU8 = WS_WD8 + al256((size_t)NE * D);
constexpr size_t WS_SD = WS_WU8 + al256((size_t)NE * D);
constexpr size_t WS_SU = WS_SD + al256((size_t)NE * 4);
constexpr size_t WS_WOUT8 = WS_SU + al256((size_t)NE * 4);
constexpr size_t WS_SWOUT = WS_WOUT8 + al256((size_t)D * D);
constexpr size_t WS_ABUF = WS_SWOUT + al256((size_t)D * 4);
constexpr size_t WS_END = WS_ABUF + al256((size_t)T * 128 * 4);
static_assert(WS_END <= (size_t)1024 * 1024 * 1024, "workspace");

constexpr int NWAVES = 8, NTHREADS = 512;
constexpr int TBL_GROUPS = 2 * NE / 8;
constexpr int LDS_BYTES = 147456;

struct EpiBf16 {
    static constexpr bool PERM = true, AFTER_DRAIN = false;
    bf16* O; int ldc;
    __device__ __forceinline__ void operator()(const pg8::f32x4 (&acc)[2][2][4][2], const pg8::Unit& u, int wr, int wc, int fr, int fq) const {
        const int row0 = u.pm * 256 + wr * 64 + fr, col0 = u.pn * 256 + wc * 32 + 8 * fq;
#pragma unroll
        for (int ai = 0; ai < 2; ++ai)
#pragma unroll
            for (int m = 0; m < 4; ++m) { bf16* rowp = O + (size_t)(row0 + ai * 128 + m * 16) * ldc + col0;
#pragma unroll
                for (int bj = 0; bj < 2; ++bj) { const pg8::f32x4 v0 = acc[ai][bj][m][0], v1 = acc[ai][bj][m][1];
                    pg8::u32x4 w; w.x = pg8::cvt_pk_bf16(v0[0], v0[1]); w.y = pg8::cvt_pk_bf16(v0[2], v0[3]); w.z = pg8::cvt_pk_bf16(v1[0], v1[1]); w.w = pg8::cvt_pk_bf16(v1[2], v1[3]);
                    *(pg8::u32x4*)(rowp + bj * 128) = w; } }
    }
};
struct EpiBf16Res {
    static constexpr bool PERM = false, AFTER_DRAIN = false;
    bf16* C; const float* R; int ldc; float alpha; const float* cs;
    __device__ __forceinline__ void operator()(const pg8::f32x4 (&acc)[2][2][4][2], const pg8::Unit& u, int wr, int wc, int fr, int fq) const {
        { int ln; asm volatile("v_mbcnt_lo_u32_b32 %0, -1, 0\n\tv_mbcnt_hi_u32_b32 %0, -1, %0" : "=v"(ln)); fr = ln & 15; fq = ln >> 4; }
        const int row0 = u.pm * 256 + wr * 64 + fr, col0 = u.pn * 256 + wc * 32 + 4 * fq;
#pragma unroll
        for (int ai = 0; ai < 2; ++ai)
#pragma unroll
            for (int m = 0; m < 4; ++m) { const size_t ro = (size_t)(row0 + ai * 128 + m * 16) * ldc + col0;
#pragma unroll
                for (int bj = 0; bj < 2; ++bj)
#pragma unroll
                    for (int n = 0; n < 2; ++n) { const size_t o = ro + bj * 128 + n * 16;
                        pg8::f32x4 v = acc[ai][bj][m][n];
                        if (cs) v = v * *(const pg8::f32x4*)(cs + col0 + bj * 128 + n * 16);
                        if (R) v = v + *(const pg8::f32x4*)(R + o) * alpha;
                        *(unsigned long long*)(C + o) = (unsigned long long)pg8::cvt_pk_bf16(v[0], v[1]) | ((unsigned long long)pg8::cvt_pk_bf16(v[2], v[3]) << 32); }
                asm volatile("" ::: "memory"); }
    }
};

__device__ __forceinline__ void p0_transpose_item(const float* __restrict__ W, int N, int K, int k0, int n0, bf16* WT, int drow0, LAS float* scr, int lane, unsigned* rmax = nullptr) {
#pragma unroll 8
    for (int i = 0; i < 32; ++i) { const int kk = 2 * i + (lane >> 5); scr[kk * 33 + (lane & 31)] = W[(size_t)(k0 + kk) * N + n0 + (lane & 31)]; }
    LDS_WAIT(); asm volatile("" ::: "memory");
    const int c = lane & 7;
#pragma unroll
    for (int j = 0; j < 4; ++j) { const int n = (lane >> 3) + 8 * j; const LAS float* s = scr + (8 * c) * 33 + n;
        v4u o; o.x = pk2(s[0 * 33], s[1 * 33]); o.y = pk2(s[2 * 33], s[3 * 33]); o.z = pk2(s[4 * 33], s[5 * 33]); o.w = pk2(s[6 * 33], s[7 * 33]);
        *(v4u*)(WT + (size_t)(drow0 + n) * K + k0 + 8 * c) = o;
        if (rmax) {
            float mx = fmaxf(fmaxf(fmaxf(fabsf(s[0 * 33]), fabsf(s[1 * 33])), fmaxf(fabsf(s[2 * 33]), fabsf(s[3 * 33]))), fmaxf(fmaxf(fabsf(s[4 * 33]), fabsf(s[5 * 33])), fmaxf(fabsf(s[6 * 33]), fabsf(s[7 * 33]))));
            mx = fmaxf(mx, __shfl_xor(mx, 1)); mx = fmaxf(mx, __shfl_xor(mx, 2)); mx = fmaxf(mx, __shfl_xor(mx, 4));
            if (c == 0) atomicMax(rmax + drow0 + n, __builtin_bit_cast(unsigned, mx)); } }
    LDS_WAIT(); asm volatile("" ::: "memory");
}

__device__ __forceinline__ void p0_transpose_item_f8(const float* __restrict__ W, int N, int K, int k0, int n0, unsigned char* W8T, int drow0, LAS float* scr, int lane, unsigned* rmax, signed char* etab) {
#pragma unroll 8
    for (int i = 0; i < 32; ++i) { const int kk = 2 * i + (lane >> 5); scr[kk * 33 + (lane & 31)] = W[(size_t)(k0 + kk) * N + n0 + (lane & 31)]; }
    LDS_WAIT(); asm volatile("" ::: "memory");
    const int c = lane & 7;
#pragma unroll
    for (int j = 0; j < 4; ++j) { const int n = (lane >> 3) + 8 * j; const LAS float* s = scr + (8 * c) * 33 + n;
        float v[8];
#pragma unroll
        for (int i = 0; i < 8; ++i) v[i] = s[i * 33];
        float mx = fmaxf(fmaxf(fmaxf(fabsf(v[0]), fabsf(v[1])), fmaxf(fabsf(v[2]), fabsf(v[3]))), fmaxf(fmaxf(fabsf(v[4]), fabsf(v[5])), fmaxf(fabsf(v[6]), fabsf(v[7]))));
        mx = fmaxf(mx, __shfl_xor(mx, 1)); mx = fmaxf(mx, __shfl_xor(mx, 2)); mx = fmaxf(mx, __shfl_xor(mx, 4));
        const int e = mx > 0.f ? min(max(__builtin_amdgcn_frexp_expf(mx * (1.f / 448.f)), -100), 100) : -100;
        const float sc = __builtin_amdgcn_ldexpf(1.f, -e);
        *(unsigned long long*)(W8T + (size_t)(drow0 + n) * K + k0 + 8 * c) = (unsigned long long)pk4_fp8(v[0] * sc, v[1] * sc, v[2] * sc, v[3] * sc) | ((unsigned long long)pk4_fp8(v[4] * sc, v[5] * sc, v[6] * sc, v[7] * sc) << 32);
        if (c == 0) { etab[(size_t)(drow0 + n) * (K / 64) + (k0 >> 6)] = (signed char)e; atomicMax(rmax + drow0 + n, __builtin_bit_cast(unsigned, mx)); } }
    LDS_WAIT(); asm volatile("" ::: "memory");
}
__device__ __forceinline__ void rescale_rows_fp8(unsigned char* w8, const signed char* etab, float* sw, const unsigned* rmax, int nrows, float post, int lane, int wave) {
    const int n0 = blockIdx.x * NWAVES + wave, NGW = gridDim.x * NWAVES;
    if (n0 >= nrows) return;
    unsigned mxn = rmax[n0]; int ebn = (int)etab[(size_t)n0 * 64 + lane];
    v4u tn[4];
#pragma unroll
    for (int q = 0; q < 4; ++q) tn[q] = *((const v4u*)(w8 + (size_t)n0 * D + 64 * lane) + q);
    for (int n = n0; n < nrows; n += NGW) {
        const float m = __builtin_bit_cast(float, mxn); const int eb = ebn;
        v4u t[4];
#pragma unroll
        for (int q = 0; q < 4; ++q) t[q] = tn[q];
        if (n + NGW < nrows) { const int nn = n + NGW; mxn = rmax[nn]; ebn = (int)etab[(size_t)nn * 64 + lane];
#pragma unroll
            for (int q = 0; q < 4; ++q) tn[q] = *((const v4u*)(w8 + (size_t)nn * D + 64 * lane) + q); }
        const int er = m > 0.f ? min(max(__builtin_amdgcn_frexp_expf(m * (1.f / 448.f)), -100), 100) : -100;
        const int sh = er - eb;
        if (sh > 0) {
            const float f = __builtin_amdgcn_ldexpf(1.f, -sh);
            v4u* p = (v4u*)(w8 + (size_t)n * D + 64 * lane);
#pragma unroll
            for (int q = 0; q < 4; ++q) { v4u tt = t[q];
#pragma unroll
                for (int d = 0; d < 4; ++d) { const f32x2v lo = __builtin_amdgcn_cvt_pk_f32_fp8((int)tt[d], false), hi = __builtin_amdgcn_cvt_pk_f32_fp8((int)tt[d], true);
                    int o = 0; o = __builtin_amdgcn_cvt_pk_fp8_f32(lo[0] * f, lo[1] * f, o, false); o = __builtin_amdgcn_cvt_pk_fp8_f32(hi[0] * f, hi[1] * f, o, true); tt[d] = (unsigned)o; }
                p[q] = tt; }
        }
        if (lane == 0) sw[n] = __builtin_amdgcn_ldexpf(1.f, er) * post;
    }
}

__device__ __forceinline__ void quant_rows_fp8(const bf16* wt, unsigned char* w8, float* sw, const unsigned* rmax, int nrows, float post, int lane, int wave) {
    for (int n = blockIdx.x * NWAVES + wave; n < nrows; n += gridDim.x * NWAVES) {
        const float m = __builtin_bit_cast(float, rmax[n]); const float inv = m > 0.f ? 448.f / m : 0.f;
#pragma unroll
        for (int j = 0; j < 4; ++j) {
            const bf16* src = wt + (size_t)n * D + 1024 * j + 16 * lane;
            const v4u a0 = *(const v4u*)src, a1 = *(const v4u*)(src + 8);
            v4u o; o.x = pk4_fp8(bflo(a0.x) * inv, bfhi(a0.x) * inv, bflo(a0.y) * inv, bfhi(a0.y) * inv); o.y = pk4_fp8(bflo(a0.z) * inv, bfhi(a0.z) * inv, bflo(a0.w) * inv, bfhi(a0.w) * inv);
            o.z = pk4_fp8(bflo(a1.x) * inv, bfhi(a1.x) * inv, bflo(a1.y) * inv, bfhi(a1.y) * inv); o.w = pk4_fp8(bflo(a1.z) * inv, bfhi(a1.z) * inv, bflo(a1.w) * inv, bfhi(a1.w) * inv);
            *(v4u*)(w8 + (size_t)n * D + 1024 * j + 16 * lane) = o;
        }
        if (lane == 0) sw[n] = m * (1.f / 448.f) * post;
    }
}

struct Args { const float* in[16]; float* out; unsigned char* ws; int ph_lo, ph_hi; };

__device__ __forceinline__ void phase0(const Args& a, LAS unsigned char* lds, int tid, int lane, int wave) {
    const float* x = a.in[0]; const float* w_in = a.in[1]; const float* w_out = a.in[7]; const float* wq = a.in[10];
    unsigned char* ws = a.ws;
    bf16* xb = (bf16*)(ws + WS_XB); bf16* win_t = (bf16*)(ws + WS_WIN); bf16* wout_t = (bf16*)(ws + WS_WOUT); bf16* wq_t = (bf16*)(ws + WS_WQ);
    float* braw = (float*)(ws + WS_BRAW);
    const int G = gridDim.x, gw = blockIdx.x * NWAVES + wave, NGW = G * NWAVES;
    for (int tt = blockIdx.x; tt < T / 32; tt += G) {
        const int t0 = tt * 32;
        f32x16 acc;
#pragma unroll
        for (int i = 0; i < 16; ++i) acc[i] = 0.f;
        const float* xa = x + (size_t)(t0 + (lane & 31)) * D + 512 * wave + 4 * (lane >> 5);
        const float* wb = w_in + (size_t)(512 * wave + 4 * (lane >> 5)) * NIN + BETA0 + (lane & 31);
        unsigned char* xq = ws + WS_XQ8 + (size_t)(t0 + (lane & 31)) * D + 512 * wave + 8 * (lane >> 5);
#pragma unroll 8
        for (int j2 = 0; j2 < 32; ++j2) {
            unsigned q8[2];
#pragma unroll
            for (int jj = 0; jj < 2; ++jj) { const int j = 2 * j2 + jj;
                const f32x4 v = *(const f32x4*)(xa + 8 * j);
                float b[4];
#pragma unroll
                for (int c = 0; c < 4; ++c) b[c] = wb[(size_t)(8 * j + c) * NIN];
                q8[jj] = pk4_fp8(v[0] * XQ_SCALE, v[1] * XQ_SCALE, v[2] * XQ_SCALE, v[3] * XQ_SCALE);
#pragma unroll
                for (int c = 0; c < 4; ++c) acc = __builtin_amdgcn_mfma_f32_32x32x2f32(v[c], b[c], acc, 0, 0, 0);
            }
            const auto sw = __builtin_amdgcn_permlane32_swap(q8[0], q8[1], false, false);
            *(unsigned long long*)(xq + 16 * j2) = (unsigned long long)sw[0] | ((unsigned long long)sw[1] << 32);
        }
        LAS float* part = (LAS float*)lds;
#pragma unroll
        for (int r = 0; r < 16; ++r) part[(wave * 16 + r) * 64 + lane] = acc[r];
        __syncthreads();
        for (int e = tid; e < 1024; e += NTHREADS) {
            float s = 0.f;
#pragma unroll
            for (int w = 0; w < 8; ++w) s += part[w * 1024 + e];
            const int r = e >> 6, l = e & 63;
            const int row = (r & 3) + 8 * (r >> 2) + 4 * (l >> 5), col = l & 31;
            braw[(size_t)(t0 + row) * 32 + col] = s;
        }
        __syncthreads();
    }
    {
        const float* keys = a.in[11]; bf16* keysb = (bf16*)(ws + WS_KEYSB);
        const size_t n8 = (size_t)PH * 2 * PN * 128 / 8;
        for (size_t i = (size_t)blockIdx.x * NTHREADS + tid; i < n8; i += (size_t)G * NTHREADS) {
            const f32x4 v0 = *(const f32x4*)(keys + i * 8), v1 = *(const f32x4*)(keys + i * 8 + 4);
            v4u o; o.x = pk2(v0[0], v0[1]); o.y = pk2(v0[2], v0[3]); o.z = pk2(v1[0], v1[1]); o.w = pk2(v1[2], v1[3]);
            *(v4u*)(keysb + i * 8) = o;
        }
    }
    {
        LAS float* scr = (LAS float*)(lds + wave * 16384);
        constexpr int NB_IN = NIN / 32;
        constexpr int I_IN = (D / 64) * NB_IN, I_OUT = (D / 64) * (D / 32), I_Q = (D / 64) * (NQ / 32);
        for (int it = gw; it < I_IN + I_OUT + I_Q; it += NGW) {
            int r = it;
            if (r < I_IN) { const int kb = r / NB_IN, nb = r % NB_IN; if (nb == 256) continue;
                p0_transpose_item_f8(w_in, NIN, D, 64 * kb, 32 * nb, ws + WS_WIN8, 32 * (nb > 256 ? nb - 1 : nb), scr, lane, (unsigned*)(ws + WS_CTL + CTL_WIMAX), (signed char*)(ws + WS_ETAB_IN)); continue; }
            r -= I_IN;
            if (r < I_OUT) { const int kb = r / (D / 32), nb = r % (D / 32); p0_transpose_item_f8(w_out, D, D, 64 * kb, 32 * nb, ws + WS_WOUT8, 32 * nb, scr, lane, (unsigned*)(ws + WS_CTL + CTL_WOMAX), (signed char*)(ws + WS_ETAB_OUT)); continue; }
            r -= I_OUT;
            { const int kb = r / (NQ / 32), nb = r % (NQ / 32); p0_transpose_item(wq, NQ, D, 64 * kb, 32 * nb, wq_t, 32 * nb, scr, lane); }
        }
    }
    __syncthreads();
}

__device__ __forceinline__ void phase_ln1(const Args& a, int lane, int wave) {
    const bf16* pre = (const bf16*)(a.ws + WS_PRE1); bf16* x1b = (bf16*)(a.ws + WS_X1B);
    const float* g = a.in[8]; const float* bb = a.in[9];
    const int gw = blockIdx.x * NWAVES + wave, NGW = gridDim.x * NWAVES;
    v4u raw[8];
    if (gw < T) { const v4u* xr = (const v4u*)(pre + (size_t)gw * D) + lane;
#pragma unroll
        for (int j = 0; j < 8; ++j) raw[j] = __builtin_nontemporal_load(xr + 64 * j); }
    for (int m = gw; m < T; m += NGW) {
        f32x4 v[16]; float s = 0.f;
#pragma unroll
        for (int j = 0; j < 8; ++j) { v[2 * j] = (f32x4){bflo(raw[j].x), bfhi(raw[j].x), bflo(raw[j].y), bfhi(raw[j].y)}; v[2 * j + 1] = (f32x4){bflo(raw[j].z), bfhi(raw[j].z), bflo(raw[j].w), bfhi(raw[j].w)};
            s += ((v[2 * j][0] + v[2 * j][1]) + (v[2 * j][2] + v[2 * j][3])) + ((v[2 * j + 1][0] + v[2 * j + 1][1]) + (v[2 * j + 1][2] + v[2 * j + 1][3])); }
        if (m + NGW < T) { const v4u* xr = (const v4u*)(pre + (size_t)(m + NGW) * D) + lane;
#pragma unroll
            for (int j = 0; j < 8; ++j) raw[j] = __builtin_nontemporal_load(xr + 64 * j); }
        const float mean = wave_sum(s) * (1.f / D); float s2 = 0.f;
#pragma unroll
        for (int j = 0; j < 16; ++j) { v[j] = v[j] - mean; s2 += (v[j][0] * v[j][0] + v[j][1] * v[j][1]) + (v[j][2] * v[j][2] + v[j][3] * v[j][3]); }
        const float rstd = rsqrtf(wave_sum(s2) * (1.f / D) + LN_EPS);
#pragma unroll
        for (int j = 0; j < 8; ++j) {
            const int c = (lane + 64 * j) * 8;
            const f32x4 g0 = *(const f32x4*)(g + c), g1 = *(const f32x4*)(g + c + 4), b0 = *(const f32x4*)(bb + c), b1 = *(const f32x4*)(bb + c + 4);
            const f32x4 o0 = v[2 * j] * rstd * g0 + b0, o1 = v[2 * j + 1] * rstd * g1 + b1;
            v4u o; o.x = pk2(o0[0], o0[1]); o.y = pk2(o0[2], o0[3]); o.z = pk2(o1[0], o1[1]); o.w = pk2(o1[2], o1[3]);
            *(v4u*)(x1b + (size_t)m * D + c) = o;
        }
    }
}


typedef __bf16 bf2_t __attribute__((ext_vector_type(2)));
typedef float f2_t __attribute__((ext_vector_type(2)));
__device__ __forceinline__ unsigned pkbf(float lo, float hi) { f2_t v = {lo, hi}; return __builtin_bit_cast(unsigned, __builtin_convertvector(v, bf2_t)); }
__device__ __forceinline__ int f2ord(float f) { const int i = __builtin_bit_cast(int, f); return i ^ ((i >> 31) & 0x7fffffff); }
__device__ __forceinline__ float ord2f(int i) { return __builtin_bit_cast(float, i ^ ((i >> 31) & 0x7fffffff)); }
__device__ __forceinline__ int imax(int a, int b) { return a > b ? a : b; }
__device__ __forceinline__ int imin(int a, int b) { return a < b ? a : b; }
template <int O, int N>
__device__ __forceinline__ void bitonic_sort16(int (&v)[N]) {
#pragma unroll
    for (int k = 2; k <= 16; k <<= 1)
#pragma unroll
        for (int j = k >> 1; j > 0; j >>= 1)
#pragma unroll
            for (int i = 0; i < 16; ++i) {
                const int l = i ^ j;
                if (l > i) {
                    const int a = v[O + i], b = v[O + l], mx = imax(a, b), mn = imin(a, b);
                    if ((i & k) == 0) { v[O + i] = mx; v[O + l] = mn; } else { v[O + i] = mn; v[O + l] = mx; }
                }
            }
}
__device__ __forceinline__ void bitonic_merge16(int (&v)[16]) {
#pragma unroll
    for (int j = 8; j > 0; j >>= 1)
#pragma unroll
        for (int i = 0; i < 16; ++i) {
            const int l = i ^ j;
            if (l > i) { const int a = v[i], b = v[l]; v[i] = imax(a, b); v[l] = imin(a, b); }
        }
}
__device__ __forceinline__ void top16_of_64(int (&v)[64], int (&out)[16]) {
    bitonic_sort16<0>(v); bitonic_sort16<16>(v); bitonic_sort16<32>(v); bitonic_sort16<48>(v);
    int a[16], b[16];
#pragma unroll
    for (int i = 0; i < 16; ++i) { a[i] = imax(v[i], v[31 - i]); b[i] = imax(v[32 + i], v[63 - i]); }
    bitonic_merge16(a); bitonic_merge16(b);
#pragma unroll
    for (int i = 0; i < 16; ++i) out[i] = imax(a[i], b[15 - i]);
    bitonic_merge16(out);
}
__device__ __forceinline__ int sel4(int d0, int d1, int d2, int d3, int q) { const int lo = (q & 1) ? d1 : d0, hi = (q & 1) ? d3 : d2; return (q & 2) ? hi : lo; }


__device__ __forceinline__ void route_scores(const bf16* qpb, const bf16* keysb, int t0, int h, int p, int r, int hh, int (&M)[16]) {
    f32x16 acc[4];
#pragma unroll
    for (int nb = 0; nb < 4; ++nb)
#pragma unroll
        for (int i = 0; i < 16; ++i) acc[nb][i] = 0.f;
    const bf16* qrow = qpb + (size_t)(t0 + r) * NQ + h * PQ + p * 128 + 8 * hh;
    const bf16* krow = keysb + ((size_t)(h * 2 + p) * PN + r) * 128 + 8 * hh;
#pragma unroll 4
    for (int s = 0; s < 8; ++s) {
        const bf16x8 qf = *(const bf16x8*)(qrow + 16 * s);
#pragma unroll
        for (int nb = 0; nb < 4; ++nb) {
            const bf16x8 kf = *(const bf16x8*)(krow + (size_t)(32 * nb) * 128 + 16 * s);
            acc[nb] = __builtin_amdgcn_mfma_f32_32x32x16_bf16(kf, qf, acc[nb], 0, 0, 0);
        }
    }
    int v[64];
#pragma unroll
    for (int nb = 0; nb < 4; ++nb)
#pragma unroll
        for (int i = 0; i < 16; ++i) {
            const int n = 32 * nb + (i & 3) + 8 * (i >> 2) + 4 * hh;
            v[nb * 16 + i] = (f2ord(acc[nb][i]) & ~127) | n;
        }
    int L[16];
    top16_of_64(v, L);
#pragma unroll
    for (int i = 0; i < 16; ++i) M[i] = imax(L[i], __shfl_xor(L[15 - i], 32));
    bitonic_merge16(M);
}

__device__ __forceinline__ void phase_route(const Args& a, int lane, int wave) {
    const bf16* qpb = (const bf16*)(a.ws + WS_QPB); const bf16* keysb = (const bf16*)(a.ws + WS_KEYSB);
    int* eidx = (int*)(a.ws + WS_EIDX); float* egate = (float*)(a.ws + WS_EGATE);
    const int r = lane & 31, hh = lane >> 5;
    for (int task = blockIdx.x * NWAVES + wave; task < (T / 32) * PH; task += gridDim.x * NWAVES) {
        const int tb = task >> 3, h = task & 7, t0 = tb * 32;
        int listA[16], listB[16];
        route_scores(qpb, keysb, t0, h, 0, r, hh, listA);
        __builtin_amdgcn_sched_barrier(0);
        route_scores(qpb, keysb, t0, h, 1, r, hh, listB);
        __builtin_amdgcn_sched_barrier(0);
        float fa[16], fb[16];
#pragma unroll
        for (int i = 0; i < 16; ++i) { fa[i] = ord2f(listA[i] & ~127); fb[i] = ord2f(listB[i] & ~127); }
        int cv[64];
        {
            int c = 0;
#pragma unroll
            for (int i = 0; i < 16; ++i)
#pragma unroll
                for (int j = 0; j < 16; ++j)
                    if ((i + 1) * (j + 1) <= 16) { cv[c] = (f2ord(fa[i] + fb[j]) & ~255) | (i * 16 + j); ++c; }
#pragma unroll
            for (int q = 50; q < 64; ++q) cv[q] = (int)0x80000000;
        }
        int sel[16];
        top16_of_64(cv, sel);
        int ia[4], ib[4];
#pragma unroll
        for (int q = 0; q < 4; ++q) {
            ia[q] = (listA[4 * q] & 127) | ((listA[4 * q + 1] & 127) << 8) | ((listA[4 * q + 2] & 127) << 16) | ((listA[4 * q + 3] & 127) << 24);
            ib[q] = (listB[4 * q] & 127) | ((listB[4 * q + 1] & 127) << 8) | ((listB[4 * q + 2] & 127) << 16) | ((listB[4 * q + 3] & 127) << 24);
        }
        float val[16]; int ex[16];
        float mx = -3.0e38f;
#pragma unroll
        for (int k = 0; k < 16; ++k) {
            const int pos = sel[k] & 255, i = pos >> 4, j = pos & 15;
            val[k] = ord2f(sel[k] & ~255);
            mx = fmaxf(mx, val[k]);
            const int na = (sel4(ia[0], ia[1], ia[2], ia[3], i >> 2) >> ((i & 3) * 8)) & 127;
            const int nb_ = (sel4(ib[0], ib[1], ib[2], ib[3], j >> 2) >> ((j & 3) * 8)) & 127;
            ex[k] = na * PN + nb_;
        }
        float sum = 0.f;
#pragma unroll
        for (int k = 0; k < 16; ++k) { val[k] = __expf(val[k] - mx); sum += val[k]; }
        const float inv = 1.f / sum;
        if (hh == 0) {
            const size_t ob = ((size_t)(t0 + r) * PH + h) * PK;
#pragma unroll
            for (int q = 0; q < 4; ++q) {
                *(v4u*)(eidx + ob + 4 * q) = (v4u){(unsigned)ex[4 * q], (unsigned)ex[4 * q + 1], (unsigned)ex[4 * q + 2], (unsigned)ex[4 * q + 3]};
                *(f32x4*)(egate + ob + 4 * q) = (f32x4){val[4 * q] * inv, val[4 * q + 1] * inv, val[4 * q + 2] * inv, val[4 * q + 3] * inv};
            }
        }
    }
}


typedef float f32x2v __attribute__((ext_vector_type(2)));
__device__ __forceinline__ float wave_max(float v) {
#pragma unroll
    for (int o = 1; o < 64; o <<= 1) v = fmaxf(v, __shfl_xor(v, o));
    return v;
}
__device__ __forceinline__ void p0_tables(const Args& a, LAS unsigned char* lds, int lane, int wave, int first_block, int nblocks, int grp_lo, int grp_hi) {
    LAS unsigned* stage = (LAS unsigned*)lds;
    int grp = grp_lo + (int)blockIdx.x - first_block;
    if (grp >= grp_hi) return;
    f32x4 v[16];
    {   const int row = grp * 8 + wave, up = row >= NE, e = up ? row - NE : row;
        const float* src = (up ? a.in[13] : a.in[12]) + (size_t)e * D;
#pragma unroll
        for (int j = 0; j < 16; ++j) v[j] = __builtin_nontemporal_load((const f32x4*)(src + 4 * (lane + 64 * j))); }
    for (; grp < grp_hi; grp += nblocks) {
        const int row = grp * 8 + wave, up = row >= NE, e = up ? row - NE : row;
        float* scl = (float*)(a.ws + (up ? WS_SU : WS_SD));
        float m = 0.f;
#pragma unroll
        for (int j = 0; j < 16; ++j) m = fmaxf(fmaxf(m, fmaxf(fabsf(v[j][0]), fabsf(v[j][1]))), fmaxf(fabsf(v[j][2]), fabsf(v[j][3])));
        m = wave_max(m);
        const float inv = m > 0.f ? 440.f / m : 0.f;
#pragma unroll
        for (int j = 0; j < 16; ++j) {
            int p = 0;
            p = __builtin_amdgcn_cvt_pk_fp8_f32(v[j][0] * inv, v[j][1] * inv, p, false);
            p = __builtin_amdgcn_cvt_pk_fp8_f32(v[j][2] * inv, v[j][3] * inv, p, true);
            stage[wave * 1024 + lane + 64 * j] = (unsigned)p;
        }
        if (lane == 0) scl[e] = m * (1.f / 440.f);
        if (grp + nblocks < grp_hi) {
            const int rown = (grp + nblocks) * 8 + wave, upn = rown >= NE, en = upn ? rown - NE : rown;
            const float* src = (upn ? a.in[13] : a.in[12]) + (size_t)en * D;
#pragma unroll
            for (int j = 0; j < 16; ++j) v[j] = __builtin_nontemporal_load((const f32x4*)(src + 4 * (lane + 64 * j)));
        }
        LDS_WAIT(); __builtin_amdgcn_s_barrier();
        {
            const int e0 = (grp * 8) % NE, r8 = lane >> 3, pc = lane & 7;
            unsigned char* dstb = a.ws + ((grp * 8 >= NE) ? WS_WU8 : WS_WD8);
#pragma unroll
            for (int q = 0; q < 4; ++q) {
                const int ds = wave * 4 + q;
                const v4u t = *(const LAS v4u*)(stage + r8 * 1024 + ds * 32 + pc * 4);
                __builtin_nontemporal_store(t, (v4u*)(dstb + (size_t)ds * (NE * 128) + (size_t)(e0 + r8) * 128 + pc * 16));
            }
        }
        LDS_WAIT(); __builtin_amdgcn_s_barrier();
    }
}

__device__ __forceinline__ float dot16_fp8(const v4u w, const f32x4 (&x)[4], float p) {
#pragma unroll
    for (int q = 0; q < 4; ++q) {
        const f32x2v lo = __builtin_amdgcn_cvt_pk_f32_fp8((int)w[q], false), hi = __builtin_amdgcn_cvt_pk_f32_fp8((int)w[q], true);
        p = fmaf(lo[0], x[q][0], p); p = fmaf(lo[1], x[q][1], p); p = fmaf(hi[0], x[q][2], p); p = fmaf(hi[1], x[q][3], p);
    }
    return p;
}


typedef int i32x4v __attribute__((ext_vector_type(4)));
typedef _Float16 h2v __attribute__((ext_vector_type(2)));
#define BF8_H(w, sel) __builtin_bit_cast(h2v, __builtin_amdgcn_perm((unsigned)(w), 0u, (sel)))
#define FP8_H(w, hi) __builtin_bit_cast(h2v, __builtin_amdgcn_cvt_scalef32_pk_f16_fp8((int)(w), 0.00390625f, (hi)))
__device__ __forceinline__ v4u tbl_load(__amdgpu_buffer_rsrc_t rs, unsigned voff, unsigned soff) {
    return __builtin_bit_cast(v4u, __builtin_amdgcn_raw_buffer_load_b128(rs, (int)voff, (int)soff, 0)); }

template <int PROBE>
__device__ __forceinline__ void phase_expert_down(const Args& a, int lane, int wave) {
    unsigned char* ws = a.ws;
    const float* sd = (const float*)(ws + WS_SD); const float* su = (const float*)(ws + WS_SU);
    const int* eidx = (const int*)(ws + WS_EIDX); const float* egate = (const float*)(ws + WS_EGATE);
    const bf16* x1b = (const bf16*)(ws + WS_X1B); float* abuf = (float*)(ws + (PROBE ? WS_XB : WS_ABUF));
    const __amdgpu_buffer_rsrc_t rs = __builtin_amdgcn_make_buffer_rsrc((void*)(ws + WS_WD8), 0, NE * D, 0x00020000);
    const int r8 = lane >> 3, pc = lane & 7;
    for (int tb = blockIdx.x * NWAVES + wave; tb < T / 4; tb += gridDim.x * NWAVES) {
        const int t0 = tb * 4;
        unsigned epk[4][8];
#pragma unroll
        for (int q = 0; q < 4; ++q)
#pragma unroll
            for (int k = 0; k < 8; ++k) epk[q][k] = (unsigned)eidx[(size_t)(t0 + q) * 128 + 8 * (2 * k) + r8] | ((unsigned)eidx[(size_t)(t0 + q) * 128 + 8 * (2 * k + 1) + r8] << 16);
        const unsigned pco = (unsigned)pc * 16u;
        float acc[4][16];
#pragma unroll
        for (int q = 0; q < 4; ++q)
#pragma unroll
            for (int k = 0; k < 16; ++k) acc[q][k] = 0.f;
#define DN_LD(dst, q, kh, so) _Pragma("unroll") for (int k = 0; k < 8; ++k) { const int kk_ = (kh) + k; unsigned eo_ = ((((kk_ & 1) ? (epk[q][kk_ >> 1] >> 16) : (epk[q][kk_ >> 1] & 0xffffu)) << 7) + pco); \
            if (PROBE == 1) eo_ &= 0xffffu; dst[k] = tbl_load(rs, eo_, so); }
#define DN_MM(src, q, kh) _Pragma("unroll") for (int k = 0; k < 8; ++k) { h2v t_ = (h2v){(_Float16)0.f, (_Float16)0.f}; \
            _Pragma("unroll") for (int d = 0; d < 4; ++d) { t_ = __builtin_elementwise_fma(FP8_H(src[k][d], false), xs[2 * d], t_); t_ = __builtin_elementwise_fma(FP8_H(src[k][d], true), xs[2 * d + 1], t_); } \
            acc[q][(kh) + k] += (float)t_[0] + (float)t_[1]; }
#define DN_XS(xa_, xb_) _Pragma("unroll") for (int i = 0; i < 4; ++i) { xs[i] = __builtin_convertvector((f32x2v){bflo(xa_[i]), bfhi(xa_[i])}, h2v); xs[4 + i] = __builtin_convertvector((f32x2v){bflo(xb_[i]), bfhi(xb_[i])}, h2v); }
#define DN_SBR() __builtin_amdgcn_sched_barrier(0)
        v4u wa[8], wb[8], xna, xnb;
        h2v xs[8];
        { const bf16* xp = x1b + (size_t)t0 * D + pc * 16; xna = *(const v4u*)xp; xnb = *(const v4u*)(xp + 8); }
        DN_LD(wa, 0, 0, 0u);
        for (int ds = 0; ds < 32; ++ds) {
            const unsigned soff = (unsigned)ds * (unsigned)(NE * 128);
            const unsigned soffn = (unsigned)(ds + 1 < 32 ? ds + 1 : ds) * (unsigned)(NE * 128);
#pragma unroll
            for (int q = 0; q < 4; ++q)
#pragma unroll
                for (int k = 0; k < 8; ++k) asm volatile("" : "+v"(epk[q][k]));
#pragma unroll
            for (int q = 0; q < 4; ++q) {
                DN_XS(xna, xnb);
                { const int qn = (q + 1) & 3, dn = (q == 3) ? (ds + 1 < 32 ? ds + 1 : 31) : ds;
                  const bf16* xp = x1b + (size_t)(t0 + qn) * D + dn * 128 + pc * 16; xna = *(const v4u*)xp; xnb = *(const v4u*)(xp + 8); }
                DN_LD(wb, q, 8, soff);
                DN_SBR(); DN_MM(wa, q, 0); DN_SBR();
                if (q < 3) { DN_LD(wa, q + 1, 0, soff); } else { DN_LD(wa, 0, 0, soffn); }
                DN_SBR(); DN_MM(wb, q, 8); DN_SBR();
            }
        }
#undef DN_LD
#undef DN_MM
#undef DN_XS
#undef DN_SBR
#pragma unroll
        for (int q = 0; q < 4; ++q)
#pragma unroll
            for (int k0 = 0; k0 < 16; k0 += 8) {
                float r4[4], r2[2];
#pragma unroll
                for (int k = 0; k < 4; ++k) { const bool o = lane & 1; const float keep = o ? acc[q][k0 + 2 * k + 1] : acc[q][k0 + 2 * k], send = o ? acc[q][k0 + 2 * k] : acc[q][k0 + 2 * k + 1]; r4[k] = keep + __shfl_xor(send, 1); }
#pragma unroll
                for (int k = 0; k < 2; ++k) { const bool o = lane & 2; const float keep = o ? r4[2 * k + 1] : r4[2 * k], send = o ? r4[2 * k] : r4[2 * k + 1]; r2[k] = keep + __shfl_xor(send, 2); }
                const bool o = lane & 4; const float keep = o ? r2[1] : r2[0], send = o ? r2[0] : r2[1];
                const float z = keep + __shfl_xor(send, 4);
                const size_t pi = (size_t)(t0 + q) * 128 + 8 * (k0 + pc) + r8;
                const int e = eidx[pi];
                abuf[pi] = gelu_f(z * (256.f * sd[e])) * egate[pi] * (256.f * su[e]);
            }
    }
}

template <int PROBE>
__device__ __forceinline__ void phase_expert_up(const Args& a, LAS unsigned char* lds, int lane, int wave) {
    unsigned char* ws = a.ws;
    const int* eidx = (const int*)(ws + WS_EIDX);
    const bf16* x1b = (const bf16*)(ws + WS_X1B); const float* abuf = (const float*)(ws + WS_ABUF); float* out = a.out;
    bf16* vb16 = (bf16*)(ws + WS_PRE1);
    const float* g2 = a.in[14]; const float* b2 = a.in[15];
    const __amdgpu_buffer_rsrc_t rs = __builtin_amdgcn_make_buffer_rsrc((void*)(ws + WS_WU8), 0, NE * D, 0x00020000);
    const int r8 = lane >> 3, pc = lane & 7;
    LAS unsigned* lw = (LAS unsigned*)(lds + wave * 16384) + lane;
    for (int tb = blockIdx.x * NWAVES + wave; tb < T / 4; tb += gridDim.x * NWAVES) {
        const int t0 = tb * 4;
#pragma unroll
        for (int q = 0; q < 4; ++q) {
#pragma unroll
            for (int k = 0; k < 8; ++k) {
                lw[(q * 16 + k) * 64] = (unsigned)eidx[(size_t)(t0 + q) * 128 + 8 * (2 * k) + r8] | ((unsigned)eidx[(size_t)(t0 + q) * 128 + 8 * (2 * k + 1) + r8] << 16);
                lw[(q * 16 + 8 + k) * 64] = __builtin_bit_cast(unsigned, __builtin_convertvector((f32x2v){abuf[(size_t)(t0 + q) * 128 + 8 * (2 * k) + r8], abuf[(size_t)(t0 + q) * 128 + 8 * (2 * k + 1) + r8]}, h2v));
            }
        }
        LDS_WAIT();
        const unsigned pco = (unsigned)pc * 16u;
        float s1[4], s2[4];
#pragma unroll
        for (int q = 0; q < 4; ++q) { s1[q] = 0.f; s2[q] = 0.f; }
#define UP_OFF(ek, k) ((((((k) & 1) ? (ek[((k) & 7) >> 1] >> 16) : (ek[((k) & 7) >> 1] & 0xffffu)) << 7) + pco) & (PROBE ? 0xffffu : 0xffffffffu))
#define UP_EK(dst, q, kh) _Pragma("unroll") for (int j = 0; j < 4; ++j) dst[j] = lw[((q) * 16 + (kh) / 2 + j) * 64];
#define UP_LD(dst, ek, so) _Pragma("unroll") for (int k = 0; k < 8; ++k) dst[k] = tbl_load(rs, UP_OFF(ek, k), so);
#define UP_MM(src, q, kh) { unsigned ak[4]; _Pragma("unroll") for (int j = 0; j < 4; ++j) ak[j] = lw[((q) * 16 + 8 + (kh) / 2 + j) * 64]; \
        _Pragma("unroll") for (int k = 0; k < 8; ++k) { \
            const h2v ap = __builtin_bit_cast(h2v, ak[k >> 1]); const h2v s2v = (k & 1) ? (h2v){ap[1], ap[1]} : (h2v){ap[0], ap[0]}; \
            _Pragma("unroll") for (int d = 0; d < 4; ++d) { \
                y[2 * d] = __builtin_elementwise_fma(FP8_H(src[k][d], false), s2v, y[2 * d]); y[2 * d + 1] = __builtin_elementwise_fma(FP8_H(src[k][d], true), s2v, y[2 * d + 1]); } } }
#define SBR() __builtin_amdgcn_sched_barrier(0)
        v4u wa[8], wb[8];
        unsigned eka[4], ekb[4];
        { UP_EK(eka, 0, 0); UP_LD(wa, eka, 0u); UP_EK(ekb, 0, 8); }
        for (int ds = 0; ds < 32; ++ds) {
            const unsigned soff = (unsigned)ds * (unsigned)(NE * 128);
            const unsigned soffn = (unsigned)(ds + 1 < 32 ? ds + 1 : ds) * (unsigned)(NE * 128);
#pragma unroll
            for (int q = 0; q < 4; ++q) {
                h2v y[8];
#pragma unroll
                for (int i = 0; i < 8; ++i) y[i] = (h2v){(_Float16)0.f, (_Float16)0.f};
                const size_t oi = (size_t)(t0 + q) * D + ds * 128 + pc * 16 + 2 * r8;
                const unsigned xw = *(const unsigned*)(x1b + oi);
                UP_LD(wb, ekb, soff);
                if (q < 3) { UP_EK(eka, q + 1, 0); } else { UP_EK(eka, 0, 0); }
                SBR(); UP_MM(wa, q, 0); SBR();
                if (q < 3) { UP_LD(wa, eka, soff); UP_EK(ekb, q + 1, 8); } else { UP_LD(wa, eka, soffn); UP_EK(ekb, 0, 8); }
                SBR(); UP_MM(wb, q, 8); SBR();
                h2v y4[4], y2[2];
#pragma unroll
                for (int i = 0; i < 4; ++i) { const bool o = lane & 32; const h2v keep = o ? y[4 + i] : y[i], send = o ? y[i] : y[4 + i];
                    y4[i] = keep + __builtin_bit_cast(h2v, __shfl_xor(__builtin_bit_cast(int, send), 32)); }
#pragma unroll
                for (int i = 0; i < 2; ++i) { const bool o = lane & 16; const h2v keep = o ? y4[2 + i] : y4[i], send = o ? y4[i] : y4[2 + i];
                    y2[i] = keep + __builtin_bit_cast(h2v, __shfl_xor(__builtin_bit_cast(int, send), 16)); }
                f32x2v yv; { const bool o = lane & 8; const h2v keep = o ? y2[1] : y2[0], send = o ? y2[0] : y2[1];
                    const h2v yh = keep + __builtin_bit_cast(h2v, __shfl_xor(__builtin_bit_cast(int, send), 8)); yv = (f32x2v){(float)yh[0], (float)yh[1]}; }
                f32x2v v = (f32x2v){bflo(xw), bfhi(xw)} * ALPHA + yv;
                const unsigned vw = pkbf(v[0], v[1]);
                v = (f32x2v){bflo(vw), bfhi(vw)};
                s1[q] += v[0] + v[1]; s2[q] = fmaf(v[0], v[0], fmaf(v[1], v[1], s2[q]));
                *(unsigned*)(vb16 + oi) = vw;
            }
        }
#undef UP_OFF
#undef UP_EK
#undef UP_LD
#undef UP_MM
#undef SBR
#pragma unroll
        for (int q = 0; q < 4; ++q) {
            const float mean = wave_sum(s1[q]) * (1.f / D);
            const float var = wave_sum(s2[q]) * (1.f / D) - mean * mean;
            const float rstd = rsqrtf(fmaxf(var, 0.f) + LN_EPS);
            float* orow = out + (size_t)(t0 + q) * D; const bf16* vrow = vb16 + (size_t)(t0 + q) * D;
#pragma unroll
            for (int j = 0; j < 8; ++j) { const int c = 8 * (lane + 64 * j);
                const v4u vv = __builtin_nontemporal_load((const v4u*)(vrow + c));
                const f32x4 g0 = *(const f32x4*)(g2 + c), g1 = *(const f32x4*)(g2 + c + 4), b0 = *(const f32x4*)(b2 + c), b1 = *(const f32x4*)(b2 + c + 4);
                const f32x4 v0 = (f32x4){bflo(vv.x), bfhi(vv.x), bflo(vv.y), bfhi(vv.y)}, v1 = (f32x4){bflo(vv.z), bfhi(vv.z), bflo(vv.w), bfhi(vv.w)};
                __builtin_nontemporal_store((v0 - mean) * rstd * g0 + b0, (f32x4*)(orow + c)); __builtin_nontemporal_store((v1 - mean) * rstd * g1 + b1, (f32x4*)(orow + c + 4)); }
        }
    }
}


constexpr size_t GU_FR = 16 * 64 * 8 * 2;
constexpr size_t WS_G_KA = WS_PRE1;
constexpr size_t WS_G_QA = WS_G_KA + (size_t)2048 * GU_FR;
constexpr size_t WS_G_VB = WS_G_QA + (size_t)2048 * GU_FR;
constexpr size_t WS_G_KBT = WS_G_VB + (size_t)2048 * GU_FR;
constexpr size_t WS_G_KDT = WS_G_KBT + (size_t)2048 * GU_FR;
constexpr size_t WS_G_WN = WS_G_KDT + (size_t)2048 * GU_FR;
constexpr size_t WS_G_QKM = WS_G_WN + (size_t)2048 * GU_FR;
constexpr size_t WS_G_UU = WS_G_QKM + (size_t)2048 * 6 * 1024;
constexpr size_t WS_G_GC = WS_G_UU + (size_t)2048 * 32768;
constexpr size_t WS_G_BT = WS_G_GC + (size_t)2048 * 256;
constexpr size_t WS_G_END = WS_G_BT + (size_t)2048 * 256;
static_assert(WS_G_END <= WS_KEYSB, "GDN scratch must fit in the PRE1..QPB region (all written after the GDN is done)");

__device__ __forceinline__ bf16x8 ldfrag(const bf16* base, int frag, int lane) { return *(const bf16x8*)(base + ((size_t)frag * 64 + lane) * 8); }
__device__ __forceinline__ void stfrag(bf16* base, int frag, int lane, v4u v) { *(v4u*)(base + ((size_t)frag * 64 + lane) * 8) = v; }
__device__ __forceinline__ v4u pack8(float a0, float a1, float a2, float a3, float a4, float a5, float a6, float a7) {
    v4u o; o.x = pkbf(a0, a1); o.y = pkbf(a2, a3); o.z = pkbf(a4, a5); o.w = pkbf(a6, a7); return o; }
__device__ __forceinline__ bf16x8 packacc(const f32x16& x, int s) {
    return __builtin_bit_cast(bf16x8, pack8(x[8 * s], x[8 * s + 1], x[8 * s + 2], x[8 * s + 3], x[8 * s + 4], x[8 * s + 5], x[8 * s + 6], x[8 * s + 7])); }
#define MFMA32(a, b, c) __builtin_amdgcn_mfma_f32_32x32x16_bf16((a), (b), (c), 0, 0, 0)

constexpr int P2_LD = 129;
__device__ __forceinline__ void prep_load_rows(const bf16* projb, int tbase, int c, int h, int tid, v4u (&R)[11]) {
    const int ten = tid >> 7, rem = tid & 127, tg = rem >> 4, cc = rem & 15, col = ten * GW + h * GD + cc * 8;
#pragma unroll
    for (int i = 0; i < 11; ++i) {
        const int tok = tg * 8 - 3 + i;
        if (c * 64 + tok >= 0) R[i] = *(const v4u*)(projb + (size_t)(tbase + tok) * NP + col);
        else R[i] = (v4u){0u, 0u, 0u, 0u};
    }
}
__device__ __forceinline__ void phase_gdn_prep(const Args& a, LAS unsigned char* lds, int tid, int lane, int wave) {
    unsigned char* ws = a.ws;
    const bf16* projb = (const bf16*)(ws + WS_PROJ); const float* braw = (const float*)(ws + WS_BRAW);
    const float* conv_qkv = a.in[2]; const float* a_log = a.in[3]; const float* dt_bias = a.in[4];
    LAS float* xs = (LAS float*)lds;
    LAS float* ssq = xs + 3 * 64 * P2_LD;
    LAS float* gcs = ssq + 256;
    LAS float* bts = gcs + 64;
    LAS float* cw = bts + 64;
    for (int grp = blockIdx.x; grp < 256; grp += gridDim.x) {
        const int bh = grp >> 2, c0 = (grp & 3) * 8, b = bh >> 4, h = bh & 15;
        for (int e = tid; e < 4 * 384; e += NTHREADS) { const int j = e / 384, cl = e % 384; cw[e] = conv_qkv[j * 3 * GW + (cl >> 7) * GW + h * GD + (cl & 127)]; }
        if (tid < 256) ssq[tid] = 0.f;
        v4u R[11], Rn[11];
        float braw_b = 0.f, braw_a = 0.f;
        if (tid < 384) prep_load_rows(projb, b * S + c0 * 64, c0, h, tid, R);
        if (wave == 7) { const int t = b * S + c0 * 64 + lane; braw_b = braw[(size_t)t * 32 + h]; braw_a = braw[(size_t)t * 32 + 16 + h]; }
        __syncthreads();
        for (int ci = 0; ci < 8; ++ci) {
            const int c = c0 + ci, u = bh * 32 + c, sb = ci & 1;
            LAS float* sq = ssq + sb * 128;
            if (ci + 1 < 8 && tid < 384) prep_load_rows(projb, b * S + (c + 1) * 64, c + 1, h, tid, Rn);
            if (tid < 384) {
                const int ten = tid >> 7, rem = tid & 127, tg = rem >> 4, cc = rem & 15;
                float wv[4][8];
#pragma unroll
                for (int j = 0; j < 4; ++j)
#pragma unroll
                    for (int e = 0; e < 8; ++e) wv[j][e] = cw[j * 384 + ten * 128 + cc * 8 + e];
#pragma unroll
                for (int i = 0; i < 8; ++i) {
                    float acc[8];
#pragma unroll
                    for (int e = 0; e < 8; ++e) acc[e] = 0.f;
#pragma unroll
                    for (int j = 0; j < 4; ++j) { const v4u w = R[i + j];
                        acc[0] = fmaf(wv[j][0], bflo(w.x), acc[0]); acc[1] = fmaf(wv[j][1], bfhi(w.x), acc[1]); acc[2] = fmaf(wv[j][2], bflo(w.y), acc[2]); acc[3] = fmaf(wv[j][3], bfhi(w.y), acc[3]);
                        acc[4] = fmaf(wv[j][4], bflo(w.z), acc[4]); acc[5] = fmaf(wv[j][5], bfhi(w.z), acc[5]); acc[6] = fmaf(wv[j][6], bflo(w.w), acc[6]); acc[7] = fmaf(wv[j][7], bfhi(w.w), acc[7]); }
                    float s2 = 0.f; const int tok = tg * 8 + i;
#pragma unroll
                    for (int e = 0; e < 8; ++e) { acc[e] = silu_f(acc[e]); s2 = fmaf(acc[e], acc[e], s2); xs[(ten * 64 + tok) * P2_LD + cc * 8 + e] = acc[e]; }
                    if (ten < 2) atomicAdd((float*)(sq + ten * 64 + tok), s2);
                }
            }
            if (wave == 7) {
                const float be = sigmoid_f(braw_b);
                float g = -expf(a_log[h]) * softplus_f(braw_a + dt_bias[h]);
#pragma unroll
                for (int o = 1; o < 64; o <<= 1) { const float n = __shfl_up(g, o); if (lane >= o) g += n; }
                gcs[lane] = g; bts[lane] = be;
                ((float*)(ws + WS_G_GC))[(size_t)u * 64 + lane] = g; ((float*)(ws + WS_G_BT))[(size_t)u * 64 + lane] = be;
            }
            LDS_WAIT(); __builtin_amdgcn_s_barrier();
            if (ci + 1 < 8) {
                if (tid < 384) {
#pragma unroll
                    for (int i = 0; i < 11; ++i) R[i] = Rn[i];
                }
                if (wave == 7) { const int t = b * S + (c + 1) * 64 + lane; braw_b = braw[(size_t)t * 32 + h]; braw_a = braw[(size_t)t * 32 + 16 + h]; }
            }
            if (tid < 128) ssq[(sb ^ 1) * 128 + tid] = 0.f;
            const float glast = gcs[63];
#pragma unroll
            for (int i = 0; i < 10; ++i) {
                const int f = tid + 512 * i, buf = f >> 10, fr = (f >> 6) & 15, l = f & 63, r = l & 31, hh = l >> 5;
                float o[8];
                if (buf < 2) {
                    const int I = fr >> 3, s = fr & 7, ten = buf == 0 ? 1 : 0, row = 32 * I + r;
                    const float sc = rsqrtf(sq[ten * 64 + row] + RMS_EPS) * (buf == 0 ? 1.f : 0.08838834764831845f);
#pragma unroll
                    for (int j = 0; j < 8; ++j) o[j] = xs[(ten * 64 + row) * P2_LD + 16 * s + 8 * (j >> 2) + 4 * hh + (j & 3)] * sc;
                } else if (buf == 2) {
                    const int s = fr >> 2, cb = fr & 3;
#pragma unroll
                    for (int j = 0; j < 8; ++j) { const int tok = 16 * s + 8 * hh + j; o[j] = xs[(2 * 64 + tok) * P2_LD + 32 * cb + r] * bts[tok]; }
                } else if (buf == 3) {
                    const int cb = fr >> 2, s = fr & 3;
#pragma unroll
                    for (int j = 0; j < 8; ++j) { const int tok = 16 * s + 8 * hh + j;
                        o[j] = xs[(1 * 64 + tok) * P2_LD + 32 * cb + r] * (rsqrtf(sq[64 + tok] + RMS_EPS) * bts[tok] * __expf(gcs[tok])); }
                } else {
                    const int cp = fr >> 2, J = (fr >> 1) & 1, sp = fr & 1;
#pragma unroll
                    for (int j = 0; j < 8; ++j) { const int tok = 32 * J + 16 * sp + 8 * (j >> 2) + 4 * hh + (j & 3);
                        o[j] = xs[(1 * 64 + tok) * P2_LD + 32 * cp + r] * (rsqrtf(sq[64 + tok] + RMS_EPS) * __expf(glast - gcs[tok])); }
                }
                bf16* dst = (bf16*)(ws + (buf == 0 ? WS_G_KA : buf == 1 ? WS_G_QA : buf == 2 ? WS_G_VB : buf == 3 ? WS_G_KBT : WS_G_KDT)) + (size_t)u * (GU_FR / 2);
                stfrag(dst, fr, l, pack8(o[0], o[1], o[2], o[3], o[4], o[5], o[6], o[7]));
            }
            LDS_WAIT(); __builtin_amdgcn_s_barrier();
        }
    }
    {
        const float* conv_short = a.in[6]; unsigned char* cat8 = ws + WS_CAT;
        for (int item = blockIdx.x * NTHREADS + tid; item < (T / 16) * (GW / 8); item += gridDim.x * NTHREADS) {
            const int run = item >> 8, cc = item & 255, col = cc * 8, tfirst = run * 16;
            float cw3[3][8];
#pragma unroll
            for (int jt = 0; jt < 3; ++jt) { const f32x4 c0 = *(const f32x4*)(conv_short + jt * GW + col), c1 = *(const f32x4*)(conv_short + jt * GW + col + 4);
#pragma unroll
                for (int e = 0; e < 4; ++e) { cw3[jt][e] = c0[e]; cw3[jt][4 + e] = c1[e]; } }
            float p1[8], p2[8];
#pragma unroll
            for (int e = 0; e < 8; ++e) { p1[e] = 0.f; p2[e] = 0.f; }
            if ((tfirst & (S - 1)) != 0) {
                const size_t r1 = (size_t)(tfirst - 1) * NP, r2 = (size_t)(tfirst - 2) * NP;
                const v4u g1 = *(const v4u*)(projb + r1 + PGC0 + col), h1 = *(const v4u*)(projb + r1 + PH0 + col), g2 = *(const v4u*)(projb + r2 + PGC0 + col), h2 = *(const v4u*)(projb + r2 + PH0 + col);
#pragma unroll
                for (int e = 0; e < 4; ++e) { p1[2 * e] = bflo(g1[e]) * bflo(h1[e]); p1[2 * e + 1] = bfhi(g1[e]) * bfhi(h1[e]); p2[2 * e] = bflo(g2[e]) * bflo(h2[e]); p2[2 * e + 1] = bfhi(g2[e]) * bfhi(h2[e]); }
            }
#pragma unroll 4
            for (int i = 0; i < 16; ++i) {
                const size_t row = (size_t)(tfirst + i) * NP;
                const v4u gc = *(const v4u*)(projb + row + PGC0 + col), hv = *(const v4u*)(projb + row + PH0 + col), gb = *(const v4u*)(projb + row + PGB0 + col);
                float p0[8], y[8];
#pragma unroll
                for (int e = 0; e < 4; ++e) { p0[2 * e] = bflo(gc[e]) * bflo(hv[e]); p0[2 * e + 1] = bfhi(gc[e]) * bfhi(hv[e]); }
#pragma unroll
                for (int e = 0; e < 8; ++e) y[e] = fmaf(cw3[2][e], p0[e], fmaf(cw3[1][e], p1[e], cw3[0][e] * p2[e]));
                const unsigned long long o8 = (unsigned long long)pk4_fp8(y[0] * bflo(gb.x), y[1] * bfhi(gb.x), y[2] * bflo(gb.y), y[3] * bfhi(gb.y)) |
                                              ((unsigned long long)pk4_fp8(y[4] * bflo(gb.z), y[5] * bfhi(gb.z), y[6] * bflo(gb.w), y[7] * bfhi(gb.w)) << 32);
                *(unsigned long long*)(cat8 + (size_t)(tfirst + i) * D + GW + col) = o8;
#pragma unroll
                for (int e = 0; e < 8; ++e) { p2[e] = p1[e]; p1[e] = p0[e]; }
            }
        }
    }
    rescale_rows_fp8(ws + WS_WOUT8, (const signed char*)(ws + WS_ETAB_OUT), (float*)(ws + WS_SWOUT), (const unsigned*)(ws + WS_CTL + CTL_WOMAX), D, 1.f, lane, wave);
}

template <int J, int Q>
struct SubstInner {
    static __device__ __forceinline__ void run(const float (&Tr)[64], const LAS float* Mt, float& a0, float& a1) {
        if constexpr (Q < 16) {
            const f32x4 mq = *(const LAS f32x4*)(Mt + J * 64 + 4 * Q);
            if constexpr (4 * Q + 0 > J) a0 = fmaf(Tr[4 * Q + 0], mq[0], a0);
            if constexpr (4 * Q + 1 > J) a1 = fmaf(Tr[4 * Q + 1], mq[1], a1);
            if constexpr (4 * Q + 2 > J) a0 = fmaf(Tr[4 * Q + 2], mq[2], a0);
            if constexpr (4 * Q + 3 > J) a1 = fmaf(Tr[4 * Q + 3], mq[3], a1);
            SubstInner<J, Q + 1>::run(Tr, Mt, a0, a1);
        }
    }
};
template <int J>
struct SubstOuter {
    static __device__ __forceinline__ void run(float (&Tr)[64], const LAS float* Mt, int lane) {
        float a0 = 0.f, a1 = 0.f;
        SubstInner<J, (J + 1) / 4>::run(Tr, Mt, a0, a1);
        asm volatile("" : "+v"(lane));
        Tr[J] = (lane == J ? 1.f : 0.f) - (a0 + a1);
        asm volatile("" : "+v"(Mt), "+v"(Tr[J]));
        if constexpr (J > 0) SubstOuter<J - 1>::run(Tr, Mt, lane);
    }
};

__device__ __forceinline__ void phase_gdn_solve(const Args& a, LAS unsigned char* lds, int lane, int wave) {
    unsigned char* ws = a.ws;
    const int r = lane & 31, hh = lane >> 5;
    LAS float* Mt = (LAS float*)(lds + wave * 16384);
    for (int u = blockIdx.x * NWAVES + wave; u < 2048; u += gridDim.x * NWAVES) {
        const bf16* KA = (const bf16*)(ws + WS_G_KA) + (size_t)u * (GU_FR / 2); const bf16* QA = (const bf16*)(ws + WS_G_QA) + (size_t)u * (GU_FR / 2);
        const bf16* VB = (const bf16*)(ws + WS_G_VB) + (size_t)u * (GU_FR / 2); const bf16* KBT = (const bf16*)(ws + WS_G_KBT) + (size_t)u * (GU_FR / 2);
        bf16* WN = (bf16*)(ws + WS_G_WN) + (size_t)u * (GU_FR / 2); bf16* QKM = (bf16*)(ws + WS_G_QKM) + (size_t)u * (6 * 512);
        v4u* UU = (v4u*)(ws + WS_G_UU) + (size_t)u * 1024;
        const float* GC = (const float*)(ws + WS_G_GC) + (size_t)u * 64; const float* BT = (const float*)(ws + WS_G_BT) + (size_t)u * 64;
        const float gi0 = GC[r], gi1 = GC[32 + r], bi0 = BT[r], bi1 = BT[32 + r];
        f32x4 gm[2][4];
#pragma unroll
        for (int J = 0; J < 2; ++J)
#pragma unroll
            for (int g = 0; g < 4; ++g) gm[J][g] = *(const f32x4*)(GC + 32 * J + 8 * g + 4 * hh);
        {
            f32x16 q00, q10, q11;
#pragma unroll
            for (int i = 0; i < 16; ++i) { q00[i] = 0.f; q10[i] = 0.f; q11[i] = 0.f; }
#pragma unroll 2
            for (int s = 0; s < 8; ++s) {
                const bf16x8 k0 = ldfrag(KA, s, lane), k1 = ldfrag(KA, 8 + s, lane), qq0 = ldfrag(QA, s, lane), qq1 = ldfrag(QA, 8 + s, lane);
                q00 = MFMA32(k0, qq0, q00); q10 = MFMA32(k0, qq1, q10); q11 = MFMA32(k1, qq1, q11);
            }
#pragma unroll
            for (int i = 0; i < 16; ++i) {
                const int g = i >> 2, e = i & 3, mloc = e + 8 * g + 4 * hh;
                const float gj0 = gm[0][g][e], gj1 = gm[1][g][e];
                q00[i] = (mloc <= r) ? q00[i] * __expf(gi0 - gj0) : 0.f;
                q10[i] = q10[i] * __expf(gi1 - gj0);
                q11[i] = (mloc <= r) ? q11[i] * __expf(gi1 - gj1) : 0.f;
            }
            stfrag(QKM, 0, lane, __builtin_bit_cast(v4u, packacc(q00, 0))); stfrag(QKM, 1, lane, __builtin_bit_cast(v4u, packacc(q00, 1)));
            stfrag(QKM, 2, lane, __builtin_bit_cast(v4u, packacc(q10, 0))); stfrag(QKM, 3, lane, __builtin_bit_cast(v4u, packacc(q10, 1)));
            stfrag(QKM, 4, lane, __builtin_bit_cast(v4u, packacc(q11, 0))); stfrag(QKM, 5, lane, __builtin_bit_cast(v4u, packacc(q11, 1)));
        }
        __builtin_amdgcn_sched_barrier(0);
        f32x16 m00, m10, m11;
#pragma unroll
        for (int i = 0; i < 16; ++i) { m00[i] = 0.f; m10[i] = 0.f; m11[i] = 0.f; }
#pragma unroll 4
        for (int s = 0; s < 8; ++s) {
            const bf16x8 k0 = ldfrag(KA, s, lane), k1 = ldfrag(KA, 8 + s, lane);
            m00 = MFMA32(k0, k0, m00); m10 = MFMA32(k0, k1, m10); m11 = MFMA32(k1, k1, m11);
        }
#pragma unroll
        for (int i = 0; i < 16; ++i) {
            const int g = i >> 2, e = i & 3, mloc = e + 8 * g + 4 * hh;
            const float gj0 = gm[0][g][e], gj1 = gm[1][g][e];
            m00[i] = (mloc < r) ? bi0 * m00[i] * __expf(gi0 - gj0) : 0.f;
            m10[i] = bi1 * m10[i] * __expf(gi1 - gj0);
            m11[i] = (mloc < r) ? bi1 * m11[i] * __expf(gi1 - gj1) : 0.f;
        }
        int lane_o = lane; asm volatile("" : "+v"(lane_o));
        float Tr[64];
#pragma unroll
        for (int m = 0; m < 64; ++m) Tr[m] = 0.f;
        Tr[63] = (lane_o == 63) ? 1.f : 0.f;
        {
            LAS float* mb = Mt + 256 * hh + r;
#pragma unroll
            for (int i = 0; i < 16; ++i) {
                const int cc = (i & 3) + 8 * (i >> 2);
                mb[cc * 64] = m00[i]; mb[cc * 64 + 32] = m10[i]; mb[(32 + cc) * 64 + 32] = m11[i];
            }
        }
        LDS_WAIT(); asm volatile("" ::: "memory");
#ifndef DG_NOSUBST
        { const LAS float* Mt_o = Mt; asm volatile("" : "+v"(Mt_o));
          SubstOuter<62>::run(Tr, Mt_o, lane_o); }
#endif
        LDS_WAIT(); asm volatile("" ::: "memory");
        bf16x8 Tf[2][4];
#pragma unroll
        for (int s = 0; s < 4; ++s) {
            v4u X = pack8(Tr[16 * s], Tr[16 * s + 1], Tr[16 * s + 2], Tr[16 * s + 3], Tr[16 * s + 4], Tr[16 * s + 5], Tr[16 * s + 6], Tr[16 * s + 7]);
            v4u Y = pack8(Tr[16 * s + 8], Tr[16 * s + 9], Tr[16 * s + 10], Tr[16 * s + 11], Tr[16 * s + 12], Tr[16 * s + 13], Tr[16 * s + 14], Tr[16 * s + 15]);
#pragma unroll
            for (int d = 0; d < 4; ++d) { const auto sw = __builtin_amdgcn_permlane32_swap(X[d], Y[d], false, false); X[d] = sw[0]; Y[d] = sw[1]; }
            Tf[0][s] = __builtin_bit_cast(bf16x8, X); Tf[1][s] = __builtin_bit_cast(bf16x8, Y);
        }
#pragma unroll
        for (int c = 0; c < 4; ++c) {
            f32x16 u0, u1;
#pragma unroll
            for (int i = 0; i < 16; ++i) { u0[i] = 0.f; u1[i] = 0.f; }
#pragma unroll
            for (int s = 0; s < 4; ++s) { const bf16x8 vb = ldfrag(VB, s * 4 + c, lane); if (s < 2) u0 = MFMA32(Tf[0][s], vb, u0); u1 = MFMA32(Tf[1][s], vb, u1); }
#pragma unroll
            for (int q = 0; q < 2; ++q) {
                UU[((0 * 4 + c) * 2 + q) * 64 + lane] = (v4u){pk2(u0[8 * q], u0[8 * q + 1]), pk2(u0[8 * q + 2], u0[8 * q + 3]), pk2(u0[8 * q + 4], u0[8 * q + 5]), pk2(u0[8 * q + 6], u0[8 * q + 7])};
                UU[((1 * 4 + c) * 2 + q) * 64 + lane] = (v4u){pk2(u1[8 * q], u1[8 * q + 1]), pk2(u1[8 * q + 2], u1[8 * q + 3]), pk2(u1[8 * q + 4], u1[8 * q + 5]), pk2(u1[8 * q + 6], u1[8 * q + 7])}; }
        }
#pragma unroll
        for (int c = 0; c < 4; ++c) {
            f32x16 w0, w1;
#pragma unroll
            for (int i = 0; i < 16; ++i) { w0[i] = 0.f; w1[i] = 0.f; }
#pragma unroll
            for (int s = 0; s < 4; ++s) { const bf16x8 kb = ldfrag(KBT, c * 4 + s, lane); if (s < 2) w0 = MFMA32(kb, Tf[0][s], w0); w1 = MFMA32(kb, Tf[1][s], w1); }
#pragma unroll
            for (int i = 0; i < 16; ++i) { w0[i] = -w0[i]; w1[i] = -w1[i]; }
            stfrag(WN, (0 * 4 + c) * 2 + 0, lane, __builtin_bit_cast(v4u, packacc(w0, 0))); stfrag(WN, (0 * 4 + c) * 2 + 1, lane, __builtin_bit_cast(v4u, packacc(w0, 1)));
            stfrag(WN, (1 * 4 + c) * 2 + 0, lane, __builtin_bit_cast(v4u, packacc(w1, 0))); stfrag(WN, (1 * 4 + c) * 2 + 1, lane, __builtin_bit_cast(v4u, packacc(w1, 1)));
        }
    }
}

constexpr int SC_BUF = 56320;
constexpr int SC_SSL = 2 * SC_BUF;
__device__ __forceinline__ bf16x8 ldsfrag(const LAS unsigned char* buf, int frag, int lane) { return *(const LAS bf16x8*)(buf + frag * 1024 + lane * 16); }
__device__ __forceinline__ void scan_stage(unsigned char* ws, LAS unsigned char* dst, int u, int lw, int lane) {
    const unsigned char* wn = ws + WS_G_WN + (size_t)u * GU_FR; const unsigned char* qa = ws + WS_G_QA + (size_t)u * GU_FR;
    const unsigned char* kd = ws + WS_G_KDT + (size_t)u * GU_FR; const unsigned char* qk = ws + WS_G_QKM + (size_t)u * 6144;
    v4u v[14];
#pragma unroll
    for (int i = 0; i < 14; ++i) {
        const int f = lw + 4 * i;
        if (f < 54) { const unsigned char* src = f < 16 ? wn + f * 1024 : f < 32 ? qa + (f - 16) * 1024 : f < 48 ? kd + (f - 32) * 1024 : qk + (f - 48) * 1024;
            v[i] = *(const v4u*)(src + lane * 16); }
    }
    float gcv = 0.f;
    if (lw == 0) gcv = ((const float*)(ws + WS_G_GC))[(size_t)u * 64 + lane];
#pragma unroll
    for (int i = 0; i < 14; ++i) { const int f = lw + 4 * i; if (f < 54) *(LAS v4u*)(dst + f * 1024 + lane * 16) = v[i]; }
    if (lw == 0) ((LAS float*)(dst + 54 * 1024))[lane] = gcv;
    LDS_WAIT();
}
__device__ __forceinline__ void phase_gdn_scan(const Args& a, LAS unsigned char* lds, int lane, int wave) {
    unsigned char* ws = a.ws;
    const bf16* projb = (const bf16*)(ws + WS_PROJ); unsigned char* cat8 = ws + WS_CAT; const float* norm_w = a.in[5];
    LAS float* ssl = (LAS float*)(lds + SC_SSL);
    const int r = lane & 31, hh = lane >> 5, cs = wave & 3;
    const bool active = wave < 4;
    for (int bh = blockIdx.x; bh < NB * GH; bh += gridDim.x) {
        const int b = bh >> 4, h = bh & 15;
        f32x16 St[4];
#pragma unroll
        for (int cp = 0; cp < 4; ++cp)
#pragma unroll
            for (int i = 0; i < 16; ++i) St[cp][i] = 0.f;
        f32x4 nw[4];
#pragma unroll
        for (int g = 0; g < 4; ++g) nw[g] = *(const f32x4*)(norm_w + 32 * cs + 8 * g + 4 * hh);
        v4u un[2][2];
        if (active) {
            const v4u* UU = (const v4u*)(ws + WS_G_UU) + (size_t)(bh * 32) * 1024;
#pragma unroll
            for (int I = 0; I < 2; ++I)
#pragma unroll
                for (int q = 0; q < 2; ++q) un[I][q] = UU[((I * 4 + cs) * 2 + q) * 64 + lane];
        } else {
            scan_stage(ws, lds, bh * 32, wave - 4, lane);
        }
        __syncthreads();
        for (int c = 0; c < 32; ++c) {
            const int u = bh * 32 + c, buf = c & 1;
            f32x16 oT[2];
            unsigned long long zz[2][4];
            if (active) {
                const LAS unsigned char* B = lds + buf * SC_BUF;
                const LAS float* GC = (const LAS float*)(B + 54 * 1024);
                f32x16 vn[2];
#pragma unroll
                for (int I = 0; I < 2; ++I)
#pragma unroll
                    for (int q = 0; q < 2; ++q)
#pragma unroll
                        for (int j = 0; j < 4; ++j) { vn[I][8 * q + 2 * j] = bflo(un[I][q][j]); vn[I][8 * q + 2 * j + 1] = bfhi(un[I][q][j]); }
                if (c + 1 < 32) {
                    const v4u* UU = (const v4u*)(ws + WS_G_UU) + (size_t)(u + 1) * 1024;
#pragma unroll
                    for (int I = 0; I < 2; ++I)
#pragma unroll
                        for (int q = 0; q < 2; ++q) un[I][q] = UU[((I * 4 + cs) * 2 + q) * 64 + lane];
                }
#pragma unroll
                for (int I = 0; I < 2; ++I)
#pragma unroll
                    for (int g = 0; g < 4; ++g)
                        zz[I][g] = *(const unsigned long long*)(projb + (size_t)(b * S + c * 64 + 32 * I + r) * NP + Z0 + h * GD + 32 * cs + 8 * g + 4 * hh);
                bf16x8 Sf[4][2];
#pragma unroll
                for (int cp = 0; cp < 4; ++cp) { Sf[cp][0] = packacc(St[cp], 0); Sf[cp][1] = packacc(St[cp], 1); }
#pragma unroll
                for (int I = 0; I < 2; ++I) {
#pragma unroll
                    for (int i = 0; i < 16; ++i) oT[I][i] = 0.f;
#pragma unroll
                    for (int cp = 0; cp < 4; ++cp)
#pragma unroll
                        for (int sp = 0; sp < 2; ++sp) {
                            vn[I] = MFMA32(ldsfrag(B, (I * 4 + cp) * 2 + sp, lane), Sf[cp][sp], vn[I]);
                            oT[I] = MFMA32(Sf[cp][sp], ldsfrag(B, 16 + I * 8 + 2 * cp + sp, lane), oT[I]);
                        }
                    const float eg = __expf(GC[32 * I + r]);
#pragma unroll
                    for (int i = 0; i < 16; ++i) oT[I][i] *= eg;
                }
                bf16x8 Vf[2][2];
#pragma unroll
                for (int J = 0; J < 2; ++J) { Vf[J][0] = packacc(vn[J], 0); Vf[J][1] = packacc(vn[J], 1); }
#pragma unroll
                for (int sp = 0; sp < 2; ++sp) {
                    oT[0] = MFMA32(Vf[0][sp], ldsfrag(B, 48 + 0 + sp, lane), oT[0]);
                    oT[1] = MFMA32(Vf[0][sp], ldsfrag(B, 48 + 2 + sp, lane), oT[1]);
                    oT[1] = MFMA32(Vf[1][sp], ldsfrag(B, 48 + 4 + sp, lane), oT[1]);
                }
                const float dec = __expf(GC[63]);
#pragma unroll
                for (int cp = 0; cp < 4; ++cp) {
#pragma unroll
                    for (int i = 0; i < 16; ++i) St[cp][i] *= dec;
#pragma unroll
                    for (int J = 0; J < 2; ++J)
#pragma unroll
                        for (int sp = 0; sp < 2; ++sp) St[cp] = MFMA32(ldsfrag(B, 32 + cp * 4 + J * 2 + sp, lane), Vf[J][sp], St[cp]);
                }
#pragma unroll
                for (int I = 0; I < 2; ++I) {
                    float ss = 0.f;
#pragma unroll
                    for (int i = 0; i < 16; ++i) ss = fmaf(oT[I][i], oT[I][i], ss);
                    ss += __shfl_xor(ss, 32);
                    if (hh == 0) ssl[(buf * 4 + cs) * 64 + 32 * I + r] = ss;
                }
            } else if (c + 1 < 32) {
                scan_stage(ws, lds + (buf ^ 1) * SC_BUF, u + 1, wave - 4, lane);
            }
            __syncthreads();
            if (active) {
#pragma unroll
                for (int I = 0; I < 2; ++I) {
                    const int tok = 32 * I + r, t = b * S + c * 64 + tok;
                    const float tot = ssl[(buf * 4 + 0) * 64 + tok] + ssl[(buf * 4 + 1) * 64 + tok] + ssl[(buf * 4 + 2) * 64 + tok] + ssl[(buf * 4 + 3) * 64 + tok];
                    const float rstd = rsqrtf(tot * (1.f / GD) + RMS_EPS);
#pragma unroll
                    for (int g = 0; g < 4; ++g) {
                        const int dv = 32 * cs + 8 * g + 4 * hh;
                        const unsigned z01 = (unsigned)zz[I][g], z23 = (unsigned)(zz[I][g] >> 32);
                        const float o0 = oT[I][4 * g] * rstd * nw[g][0] * silu_f(bflo(z01)), o1 = oT[I][4 * g + 1] * rstd * nw[g][1] * silu_f(bfhi(z01));
                        const float o2 = oT[I][4 * g + 2] * rstd * nw[g][2] * silu_f(bflo(z23)), o3 = oT[I][4 * g + 3] * rstd * nw[g][3] * silu_f(bfhi(z23));
                        *(unsigned*)(cat8 + (size_t)t * D + h * GD + dv) = pk4_fp8(o0, o1, o2, o3);
                    }
                }
            }
        }
        __syncthreads();
    }
}


#define XB_TMO      128
#define XB_XCNT(j)  (256  + 64 * (j))
#define XB_XSUB(j)  (1280 + 64 * (j))
#define XB_XGEN(j)  (2304 + 64 * (j))
#define XB_TOP      3328
#define XB_TOPGEN   3392
#define XCD_BAR_WORDS 3456
#define XB_SPIN_CAP (1u << 18)

__device__ __forceinline__ unsigned xb_ld(unsigned* p)              { return __hip_atomic_load(p, __ATOMIC_RELAXED, __HIP_MEMORY_SCOPE_AGENT); }
__device__ __forceinline__ unsigned xb_add(unsigned* p, unsigned v) { return __hip_atomic_fetch_add(p, v, __ATOMIC_RELAXED, __HIP_MEMORY_SCOPE_AGENT); }
__device__ __forceinline__ unsigned xb_xcc_id() { return (unsigned)__builtin_amdgcn_s_getreg((3 << 11) | 20) & 0xFu; }
#define XB_SPIN(cond, bar) do { unsigned _sp = 0; while (cond) { __builtin_amdgcn_s_sleep(1); \
    if ((++_sp & 255u) == 0u) { if (xb_ld(&(bar)[XB_TMO])) break; if (_sp > XB_SPIN_CAP) { atomicAdd(&(bar)[XB_TMO], 1u); break; } } } } while (0)

struct XcdBarrier {
    unsigned* bar; unsigned x;
    volatile LAS unsigned* st;
};

__device__ __forceinline__ XcdBarrier xcd_barrier_post(unsigned* bar, volatile LAS unsigned* st) {
    XcdBarrier b; b.bar = bar; b.x = xb_xcc_id(); b.st = st;
    if (threadIdx.x == 0) (void)xb_add(&bar[XB_XCNT(b.x)], 1u);
    return b;
}
__device__ __forceinline__ void xcd_barrier_complete(unsigned* bar, unsigned x, unsigned& nloc, unsigned& nx) {
    const unsigned G = gridDim.x * gridDim.y * gridDim.z;
    unsigned sum, cnt, mine, sp = 0u;
    for (;;) {
        sum = 0u; cnt = 0u; mine = 0u;
#pragma unroll
        for (unsigned j = 0; j < 16; ++j) { const unsigned c = xb_ld(&bar[XB_XCNT(j)]); sum += c; cnt += (c > 0u) ? 1u : 0u; mine = (j == x) ? c : mine; }
        if (sum == G) break;
        __builtin_amdgcn_s_sleep(1);
        if ((++sp & 255u) == 0u) { if (xb_ld(&bar[XB_TMO])) break; if (sp > XB_SPIN_CAP) { atomicAdd(&bar[XB_TMO], 1u); break; } }
    }
    nloc = mine > 0u ? mine : 1u; nx = cnt > 0u ? cnt : 1u;
}

__device__ __forceinline__ void xcd_barrier(const XcdBarrier& b, int tid_in = -1) {
    const int tid_ = tid_in < 0 ? (int)threadIdx.x : tid_in;
    asm volatile("s_waitcnt vmcnt(0)" ::: "memory");
    __syncthreads();
    if (tid_ == 0) {
        unsigned* bar = b.bar;
        __builtin_amdgcn_s_waitcnt(0);
        unsigned nloc = b.st[0], nx = b.st[1];
        if (nloc == 0u) { xcd_barrier_complete(bar, b.x, nloc, nx); b.st[0] = nloc; b.st[1] = nx; }
        const unsigned old = xb_add(&bar[XB_XSUB(b.x)], 1u);
        const unsigned gen = old / nloc;
        if (old + 1u == (gen + 1u) * nloc) {
            __builtin_amdgcn_fence(__ATOMIC_RELEASE, "agent");
            asm volatile("s_waitcnt vmcnt(0)" ::: "memory");
            const unsigned og = xb_add(&bar[XB_TOP], 1u);
            const unsigned tg = og / nx;
            if (og + 1u == (tg + 1u) * nx) xb_add(&bar[XB_TOPGEN], 1u);
            else XB_SPIN(xb_ld(&bar[XB_TOPGEN]) == tg, bar);
            __builtin_amdgcn_fence(__ATOMIC_ACQUIRE, "agent");
            xb_add(&bar[XB_XGEN(b.x)], 1u);
            asm volatile("s_waitcnt vmcnt(0)" ::: "memory");
        } else {
            XB_SPIN(xb_ld(&bar[XB_XGEN(b.x)]) == gen, bar);
            __builtin_amdgcn_fence(__ATOMIC_ACQUIRE, "agent");
            asm volatile("s_waitcnt vmcnt(0)" ::: "memory");
        }
    }
    __syncthreads();
}

__global__ void __launch_bounds__(NTHREADS, 2) mk(Args a) {
    extern __shared__ __attribute__((aligned(16))) unsigned char lds_raw[];
    LAS unsigned char* lds = (LAS unsigned char*)lds_raw;
    cg::grid_group grid = cg::this_grid();
    const int tid = threadIdx.x, lane = tid & 63, wave = __builtin_amdgcn_readfirstlane(tid >> 6);
    volatile LAS unsigned* misc = (volatile LAS unsigned*)(lds + LDS_BYTES - 256);
    if (tid < 64) misc[tid] = 0u;
    __syncthreads();
    const XcdBarrier xbar = xcd_barrier_post((unsigned*)(a.ws + WS_CTL), misc);
    const int lo = a.ph_lo, hi = a.ph_hi;
    unsigned char* ws = a.ws;
#define IN(k) (lo <= (k) && (k) < hi)
#define SEAM(k) do { if (IN(k) && IN((k) + 1)) { if ((k) == 0 && lo < 0) grid.sync(); else xcd_barrier(xbar); } } while (0)
#define SEAM1(k) do { if (IN(k) && IN((k) + 1)) xcd_barrier(xbar, tid1); } while (0)
#define SEAM2(k) do { if (IN(k) && IN((k) + 1)) xcd_barrier(xbar, tid2); } while (0)
#define LOCAL_SEAM(k) do { if (IN(k) && IN((k) + 1)) { asm volatile("s_waitcnt vmcnt(0)" ::: "memory"); __syncthreads(); } } while (0)
    if (IN(0)) { phase0(a, lds, tid, lane, wave); }
    SEAM(0);
    if (IN(1)) {
        rescale_rows_fp8(ws + WS_WIN8, (const signed char*)(ws + WS_ETAB_IN), (float*)(ws + WS_SWIN), (const unsigned*)(ws + WS_CTL + CTL_WIMAX), NP, 1.f / XQ_SCALE, lane, wave);
        if constexpr (F8N < NP) {
            pg8::Gemm g{(const bf16*)(ws + WS_XB), (const bf16*)(ws + WS_WIN), T, NP - F8N, D}; pg8::StaticOrderSkip S; S.init(T, NP - F8N, (int)gridDim.x, (int)blockIdx.x); S.s0 = F8C0 / 256; S.sn = F8N / 256;
            EpiBf16 E{(bf16*)(ws + WS_PROJ), NP};
            pg8::gemm_phase<EpiBf16, pg8::StaticOrderSkip, true, true>(lds, g, S, E);
        }
        xcd_barrier(xbar);
        {
            pg8::Gemm g{(const bf16*)(ws + WS_XQ8), (const bf16*)(ws + WS_WIN8), T, F8N, D}; pg8::StaticOrder S; S.init(T, F8N, (int)gridDim.x, (int)blockIdx.x);
            EpiBf16Res E{(bf16*)(ws + WS_PROJ) + F8C0, nullptr, NP, 0.f, (const float*)(ws + WS_SWIN)};
            pg8::gemm_phase<EpiBf16Res, pg8::StaticOrder, true, true, true>(lds, g, S, E);
        }
    }
    int lane1; asm volatile("v_mbcnt_lo_u32_b32 %0, -1, 0\n\tv_mbcnt_hi_u32_b32 %0, -1, %0" : "=v"(lane1));
    const int tid1 = (wave * 64 + lane1) & 511;
    SEAM1(1);
    if (IN(2)) { phase_gdn_prep(a, lds, tid1, lane1, wave); }
    LOCAL_SEAM(2);
    if (IN(3)) { phase_gdn_solve(a, lds, lane1, wave); }
    SEAM1(3);
    if (IN(4)) {
        if ((int)blockIdx.x < NB * GH) phase_gdn_scan(a, lds, lane1, wave);
        if ((int)gridDim.x <= NB * GH) p0_tables(a, lds, lane1, wave, 0, (int)gridDim.x, 0, TBL_GROUPS);
        else if ((int)blockIdx.x >= NB * GH) p0_tables(a, lds, lane1, wave, NB * GH, (int)gridDim.x - NB * GH, 0, TBL_GROUPS);
    }
    SEAM1(4);
    if (IN(5)) {
        pg8::Gemm g{(const bf16*)(ws + WS_CAT), (const bf16*)(ws + WS_WOUT8), T, D, D}; pg8::StaticOrder S; S.init(T, D, (int)gridDim.x, (int)blockIdx.x);
        EpiBf16Res E{(bf16*)(ws + WS_PRE1), a.in[0], D, ALPHA, (const float*)(ws + WS_SWOUT)};
        pg8::gemm_phase<EpiBf16Res, pg8::StaticOrder, true, false, true>(lds, g, S, E, tid1);
    }
    int lane2; asm volatile("v_mbcnt_lo_u32_b32 %0, -1, 0\n\tv_mbcnt_hi_u32_b32 %0, -1, %0" : "=v"(lane2));
    const int tid2 = (wave * 64 + lane2) & 511;
    SEAM2(5);
    if (IN(6)) { phase_ln1(a, lane2, wave); }
    SEAM2(6);
    if (IN(7)) {
        pg8::Gemm g{(const bf16*)(ws + WS_X1B), (const bf16*)(ws + WS_WQ), T, NQ, D}; pg8::StaticOrder S; S.init(T, NQ, (int)gridDim.x, (int)blockIdx.x);
        EpiBf16 E{(bf16*)(ws + WS_QPB), NQ};
        pg8::gemm_phase<EpiBf16, pg8::StaticOrder, true, true>(lds, g, S, E, tid2);
    }
    SEAM2(7);
    if (IN(8)) { phase_route(a, lane2, wave); }
    LOCAL_SEAM(8);
    if (IN(9)) { phase_expert_down<0>(a, lane2, wave); }
    LOCAL_SEAM(9);
    if (IN(10)) { phase_expert_up<0>(a, lds, lane2, wave); }
#undef IN
#undef SEAM
}

static int g_grid = 0;
static void launch_mk(const Args& base, int lo, int hi, hipStream_t stream) {
    Args a = base; a.ph_lo = lo; a.ph_hi = hi;
    void* params[] = {&a};
    hipError_t e = hipLaunchCooperativeKernel((const void*)mk, dim3(g_grid), dim3(NTHREADS), params, LDS_BYTES, stream);
    if (e != hipSuccess) fprintf(stderr, "kernel_launch: cooperative launch [%d,%d) failed: %s (grid %d)\n", lo, hi, hipGetErrorString(e), g_grid);
}

extern "C" void kernel_launch(void* const* d_in, const int* in_sizes, int n_in, void* d_out, int out_size, void* d_ws, size_t ws_size,
                              hipStream_t stream) {
    (void)in_sizes; (void)n_in; (void)out_size;
    if (!g_grid) {
        int dev = 0, cus = 0, per_cu = 0;
        hipGetDevice(&dev);
        hipDeviceGetAttribute(&cus, hipDeviceAttributeMultiprocessorCount, dev);
        hipFuncSetAttribute((const void*)mk, hipFuncAttributeMaxDynamicSharedMemorySize, LDS_BYTES);
        hipOccupancyMaxActiveBlocksPerMultiprocessor(&per_cu, (const void*)mk, NTHREADS, LDS_BYTES);
        if (per_cu < 1) { fprintf(stderr, "kernel_launch: occupancy query says %d blocks/CU\n", per_cu); per_cu = 1; }
        g_grid = cus * 1;
        if (ws_size < WS_END) fprintf(stderr, "kernel_launch: workspace too small: %zu < %zu\n", ws_size, (size_t)WS_END);
    }
    Args a{};
    for (int i = 0; i < 16; ++i) a.in[i] = (const float*)d_in[i];
    a.out = (float*)d_out; a.ws = (unsigned char*)d_ws; a.ph_lo = 0; a.ph_hi = 0;
    unsigned char* ws = (unsigned char*)d_ws;

    (void)hipMemsetAsync(d_ws, 0, CTL_BYTES, stream);
    launch_mk(a, 0, 11, stream);
}
```
